# Optimizing an MI355X kernel written in HIP

```python
import jax
import jax.numpy as jnp
from jax import lax
import numpy as np


D_MODEL = 1024
BATCH = 8
SEQ = 4096
DEPTH = 4

N_MIXERS = 4
N_A = (DEPTH + 3) // 4
N_B = (DEPTH + 2) // 4
N_C = (DEPTH + 1) // 4
N_D = DEPTH // 4
HEAD_DIM = 64
NORM_EPS = 1e-5
FFN_HIDDEN = ((8 * D_MODEL + 3 * 256 - 1) // (3 * 256)) * 256

RW_HEADS = D_MODEL // HEAD_DIM
RW_N = HEAD_DIM
RW_DECAY_LORA = 64
RW_AAA_LORA = 64
RW_GATE_LORA = 128
RW_GN_EPS = 64e-5

SW_Q_HEADS = 16
SW_KV_HEADS = 2
SW_GROUP = SW_Q_HEADS // SW_KV_HEADS
SW_WINDOW = 128
SW_BLOCK = 128
ROPE_THETA = 10000.0

SG_CHUNK = 128
SG_WIDTH = 2 * D_MODEL
SG_GROUPS = 16
SG_GROUP_DIM = SG_WIDTH // SG_GROUPS

GLA_HEADS = 4
GLA_DK = D_MODEL // 2
GLA_DV = D_MODEL
GLA_HK = GLA_DK // GLA_HEADS
GLA_HV = GLA_DV // GLA_HEADS
GLA_GATE_LORA = 16
GLA_TAU = 16.0
GLA_CHUNK = 64

kernel_name = 'hybrid_interleaved_rwkv7_swa_sgu_gla'


def rmsnorm(x, g):
    xf = x.astype(jnp.float32)
    y = xf * lax.rsqrt(jnp.mean(jnp.square(xf), -1, keepdims=True) + NORM_EPS)
    return (y * g).astype(x.dtype)


def layernorm(x, g, b):
    xf = x.astype(jnp.float32)
    mu = jnp.mean(xf, -1, keepdims=True)
    var = jnp.mean(jnp.square(xf - mu), -1, keepdims=True)
    return ((xf - mu) * lax.rsqrt(var + NORM_EPS) * g + b).astype(x.dtype)


def token_shift(x):
    return jnp.pad(x[:, :-1], ((0, 0), (1, 0), (0, 0)))


def rope_tables(positions):
    f32 = jnp.float32
    inv_freq = ROPE_THETA ** (-jnp.arange(0, HEAD_DIM, 2, dtype=f32) / HEAD_DIM)
    ang = positions.astype(f32)[..., None] * inv_freq
    return jnp.cos(ang)[:, :, None, :], jnp.sin(ang)[:, :, None, :]


def apply_rope(t, cos, sin):
    half = t.shape[-1] // 2
    t1, t2 = t[..., :half], t[..., half:]
    return jnp.concatenate([t1 * cos - t2 * sin, t2 * cos + t1 * sin], -1).astype(t.dtype)


def swiglu(x, w_in, w_out):
    gate, up = jnp.split(x @ w_in, 2, axis=-1)
    return (jax.nn.silu(gate) * up) @ w_out


def rwkv7_mix(x, mu, w_rkv, w0, w1, w2, a0, a1, a2, g1, g2, k_k, k_a, r_k, gn_g, gn_b, w_o):
    B, S, D = x.shape
    H, N = RW_HEADS, RW_N
    f32 = jnp.float32
    xx = token_shift(x) - x
    xr, xw, xk, xv, xa, xg = (x + xx * mu[c] for c in range(6))
    r, k, v = jnp.einsum('cbsd,cde->cbse', jnp.stack([xr, xk, xv]), w_rkv).astype(f32)
    w = -jax.nn.softplus(-(w0 + jnp.tanh(xw @ w1) @ w2).astype(f32)) - 0.5
    a = jax.nn.sigmoid((a0 + (xa @ a1) @ a2).astype(f32))
    g = jax.nn.sigmoid(xg @ g1) @ g2
    hs = lambda t: t.reshape(B, S, H, N)
    kk = hs(k * k_k)
    kk = kk * lax.rsqrt(jnp.maximum(jnp.sum(kk * kk, -1, keepdims=True), 1e-24))
    k = k * (1.0 + (a - 1.0) * k_a)
    decay = jnp.exp(-jnp.exp(w))

    def step(state, inp):
        r_t, d_t, k_t, v_t, kk_t, a_t = inp
        sa = jnp.einsum('bhvk,bhk->bhv', state, kk_t)
        state = (state * d_t[:, :, None, :]
                 - sa[..., None] * (kk_t * a_t)[:, :, None, :]
                 + v_t[..., None] * k_t[:, :, None, :])
        return state, jnp.einsum('bhvk,bhk->bhv', state, r_t)

    seq_first = lambda t: jnp.moveaxis(t, 1, 0)
    xs = tuple(seq_first(t) for t in (hs(r), hs(decay), hs(k), hs(v), kk, hs(a)))
    _, y = lax.scan(step, jnp.zeros((B, H, N, N), f32), xs)
    y = jnp.moveaxis(y, 0, 1)
    mean = jnp.mean(y, -1, keepdims=True)
    var = jnp.mean(jnp.square(y - mean), -1, keepdims=True)
    y = ((y - mean) * lax.rsqrt(var + RW_GN_EPS)).reshape(B, S, D) * gn_g + gn_b
    bonus = (jnp.sum(hs(r) * hs(k) * r_k, -1, keepdims=True) * hs(v)).reshape(B, S, D)
    return ((y + bonus).astype(x.dtype) * g) @ w_o


def swa_sink_mix(x, cos, sin, w_qkv, b_qkv, sinks, w_o, b_o):
    B, S, _ = x.shape
    f32 = jnp.float32
    qd = SW_Q_HEADS * HEAD_DIM
    kd = SW_KV_HEADS * HEAD_DIM
    qkv = x @ w_qkv + b_qkv
    q = apply_rope(qkv[..., :qd].reshape(B, S, SW_Q_HEADS, HEAD_DIM), cos, sin)
    k = apply_rope(qkv[..., qd:qd + kd].reshape(B, S, SW_KV_HEADS, HEAD_DIM), cos, sin)
    v = qkv[..., qd + kd:].reshape(B, S, SW_KV_HEADS, HEAD_DIM)
    nb = S // SW_BLOCK
    qb = q.reshape(B, nb, SW_BLOCK, SW_KV_HEADS, SW_GROUP, HEAD_DIM)

    def band(t):
        tb = t.reshape(B, nb, SW_BLOCK, SW_KV_HEADS, HEAD_DIM)
        prev = jnp.pad(tb[:, :-1], ((0, 0), (1, 0), (0, 0), (0, 0), (0, 0)))
        return jnp.concatenate([prev, tb], axis=2)

    kw, vw = band(k), band(v)
    s = jnp.einsum('bnqhgd,bnkhd->bnhgqk', qb, kw).astype(f32) * (HEAD_DIM ** -0.5)
    qi = jnp.arange(SW_BLOCK)[:, None]
    kj = jnp.arange(2 * SW_BLOCK)[None, :]
    rel = qi + SW_BLOCK - kj
    blk = jnp.arange(nb)[:, None, None]
    valid = (rel >= 0) & (rel < SW_WINDOW) & (blk * SW_BLOCK + kj - SW_BLOCK >= 0)
    s = jnp.where(valid[None, :, None, None], s, -jnp.inf)
    sink = sinks.astype(f32).reshape(SW_KV_HEADS, SW_GROUP)[None, None, :, :, None, None]
    m = jnp.maximum(jnp.max(s, -1, keepdims=True), sink)
    p = jnp.exp(s - m)
    p = p / (jnp.sum(p, -1, keepdims=True) + jnp.exp(sink - m))
    o = jnp.einsum('bnhgqk,bnkhd->bnqhgd', p.astype(x.dtype), vw).reshape(B, S, qd)
    return o @ w_o + b_o


def sgu_chunk_mix(x, w_in, b_in, ln_g, ln_b, w_s, b_s, w_o, b_o):
    B, S, _ = x.shape
    h = jax.nn.gelu(x @ w_in + b_in, approximate=False)
    u, v = h[..., :SG_WIDTH], h[..., SG_WIDTH:]
    v = layernorm(v, ln_g, ln_b)
    nc = S // SG_CHUNK
    vb = v.reshape(B, nc, SG_CHUNK, SG_GROUPS, SG_GROUP_DIM)
    causal = jnp.tril(jnp.ones((SG_CHUNK, SG_CHUNK), dtype=bool))
    ws = jnp.where(causal[None], w_s, 0.0).astype(v.dtype)
    sv = jnp.einsum('gts,bnsgc->bntgc', ws, vb) + b_s.T[None, None, :, :, None]
    return (u * sv.reshape(B, S, SG_WIDTH)) @ w_o + b_o


def gla_mix(x, w_in, w_a2, b_a, gn_g, w_o):
    B, S, _ = x.shape
    f32 = jnp.float32
    H = GLA_HEADS
    proj = x @ w_in
    q, k, v, gate, a_low = jnp.split(
        proj, [GLA_DK, 2 * GLA_DK, 2 * GLA_DK + GLA_DV, 2 * GLA_DK + 2 * GLA_DV], axis=-1)
    log_a = jax.nn.log_sigmoid((a_low @ w_a2 + b_a).astype(f32)) / GLA_TAU
    nc = S // GLA_CHUNK
    shp_k = (B, nc, GLA_CHUNK, H, GLA_HK)
    shp_v = (B, nc, GLA_CHUNK, H, GLA_HV)
    q = q.astype(f32).reshape(shp_k) * (GLA_HK ** -0.5)
    k = k.astype(f32).reshape(shp_k)
    v = v.astype(f32).reshape(shp_v)
    bcum = jnp.cumsum(log_a.reshape(shp_k), axis=2)
    b_last = bcum[:, :, -1:]
    q_g = q * jnp.exp(bcum)
    k_g = k * jnp.exp(-bcum)
    k_s = k * jnp.exp(b_last - bcum)
    causal = jnp.tril(jnp.ones((GLA_CHUNK, GLA_CHUNK), dtype=bool))
    att = jnp.where(causal, jnp.einsum('bnihk,bnjhk->bnhij', q_g, k_g), 0.0)
    o_intra = jnp.einsum('bnhij,bnjhv->bnihv', att, v)

    def step(state, inp):
        qc, kc, vc, dc = inp
        o = jnp.einsum('bihk,bhkv->bihv', qc, state)
        state = state * dc[..., None] + jnp.einsum('bjhk,bjhv->bhkv', kc, vc)
        return state, o

    seq_first = lambda t: jnp.moveaxis(t, 1, 0)
    xs = (seq_first(q_g), seq_first(k_s), seq_first(v), seq_first(jnp.exp(b_last[:, :, 0])))
    _, o_inter = lax.scan(step, jnp.zeros((B, H, GLA_HK, GLA_HV), f32), xs)
    o = (o_intra + jnp.moveaxis(o_inter, 0, 1)).reshape(B, S, H, GLA_HV)
    o = o * lax.rsqrt(jnp.mean(jnp.square(o), -1, keepdims=True) + NORM_EPS)
    o = (o.reshape(B, S, GLA_DV) * gn_g).astype(x.dtype)
    return (o * jax.nn.silu(gate)) @ w_o


def setup_inputs(seed: int = 0) -> dict:
    key = jax.random.key(seed)
    ks = iter(jax.random.split(key, 64))
    f32 = jnp.float32
    D = D_MODEL

    def nrm(shape, scale):
        return jax.random.normal(next(ks), shape, f32) * scale

    def uni(shape, lo, hi):
        return jax.random.uniform(next(ks), shape, f32, lo, hi)

    sw_qkv_dim = (SW_Q_HEADS + 2 * SW_KV_HEADS) * HEAD_DIM
    gla_in_dim = 2 * GLA_DK + 2 * GLA_DV + GLA_GATE_LORA
    return {
        'x': nrm((BATCH, SEQ, D), 1.0),
        'positions': jnp.broadcast_to(jnp.arange(SEQ, dtype=jnp.int32), (BATCH, SEQ)),
        'norm_mix': 1.0 + nrm((DEPTH, D), 0.02),
        'norm_ffn': 1.0 + nrm((DEPTH, D), 0.02),
        'ffn_w_in': nrm((DEPTH, D, 2 * FFN_HIDDEN), D ** -0.5),
        'ffn_w_out': nrm((DEPTH, FFN_HIDDEN, D), FFN_HIDDEN ** -0.5),
        'norm_final': 1.0 + nrm((D,), 0.02),
        'rw_mu': uni((N_A, 6, D), 0.0, 1.0),
        'rw_w_rkv': nrm((N_A, 3, D, D), D ** -0.5),
        'rw_w0': nrm((N_A, D), 1.0) - 1.0,
        'rw_w1': nrm((N_A, D, RW_DECAY_LORA), D ** -0.5),
        'rw_w2': nrm((N_A, RW_DECAY_LORA, D), 0.5 * RW_DECAY_LORA ** -0.5),
        'rw_a0': nrm((N_A, D), 0.1),
        'rw_a1': nrm((N_A, D, RW_AAA_LORA), D ** -0.5),
        'rw_a2': nrm((N_A, RW_AAA_LORA, D), 0.5 * RW_AAA_LORA ** -0.5),
        'rw_g1': nrm((N_A, D, RW_GATE_LORA), D ** -0.5),
        'rw_g2': nrm((N_A, RW_GATE_LORA, D), RW_GATE_LORA ** -0.5),
        'rw_k_k': 0.85 + nrm((N_A, D), 0.02),
        'rw_k_a': 1.0 + nrm((N_A, D), 0.02),
        'rw_r_k': nrm((N_A, RW_HEADS, RW_N), 0.1),
        'rw_gn_g': 1.0 + nrm((N_A, D), 0.02),
        'rw_gn_b': nrm((N_A, D), 0.02),
        'rw_w_o': nrm((N_A, D, D), D ** -0.5),
        'sw_w_qkv': nrm((N_B, D, sw_qkv_dim), D ** -0.5),
        'sw_b_qkv': nrm((N_B, sw_qkv_dim), 0.02),
        'sw_sinks': nrm((N_B, SW_Q_HEADS), 1.0),
        'sw_w_o': nrm((N_B, SW_Q_HEADS * HEAD_DIM, D), (SW_Q_HEADS * HEAD_DIM) ** -0.5),
        'sw_b_o': nrm((N_B, D), 0.02),
        'sg_w_in': nrm((N_C, D, 2 * SG_WIDTH), D ** -0.5),
        'sg_b_in': nrm((N_C, 2 * SG_WIDTH), 0.02),
        'sg_ln_g': 1.0 + nrm((N_C, SG_WIDTH), 0.02),
        'sg_ln_b': nrm((N_C, SG_WIDTH), 0.02),
        'sg_w_s': nrm((N_C, SG_GROUPS, SG_CHUNK, SG_CHUNK), SG_CHUNK ** -0.5),
        'sg_b_s': 1.0 + nrm((N_C, SG_GROUPS, SG_CHUNK), 0.02),
        'sg_w_o': nrm((N_C, SG_WIDTH, D), SG_WIDTH ** -0.5),
        'sg_b_o': nrm((N_C, D), 0.02),
        'gla_w_in': nrm((N_D, D, gla_in_dim), D ** -0.5),
        'gla_w_a2': nrm((N_D, GLA_GATE_LORA, GLA_DK), GLA_GATE_LORA ** -0.5),
        'gla_b_a': nrm((N_D, GLA_DK), 0.1),
        'gla_gn_g': 1.0 + nrm((N_D, GLA_DV), 0.02),
        'gla_w_o': nrm((N_D, GLA_DV, D), GLA_DV ** -0.5),
    }


def reference(x, positions, norm_mix, norm_ffn, ffn_w_in, ffn_w_out, norm_final,
              rw_mu, rw_w_rkv, rw_w0, rw_w1, rw_w2, rw_a0, rw_a1, rw_a2, rw_g1, rw_g2,
              rw_k_k, rw_k_a, rw_r_k, rw_gn_g, rw_gn_b, rw_w_o,
              sw_w_qkv, sw_b_qkv, sw_sinks, sw_w_o, sw_b_o,
              sg_w_in, sg_b_in, sg_ln_g, sg_ln_b, sg_w_s, sg_b_s, sg_w_o, sg_b_o,
              gla_w_in, gla_w_a2, gla_b_a, gla_gn_g, gla_w_o):
    cos, sin = rope_tables(positions)
    h = x
    for i in range(DEPTH):
        t, j = i % N_MIXERS, i // N_MIXERS
        hn = rmsnorm(h, norm_mix[i])
        if t == 0:
            m = rwkv7_mix(hn, rw_mu[j], rw_w_rkv[j], rw_w0[j], rw_w1[j], rw_w2[j],
                          rw_a0[j], rw_a1[j], rw_a2[j], rw_g1[j], rw_g2[j],
                          rw_k_k[j], rw_k_a[j], rw_r_k[j], rw_gn_g[j], rw_gn_b[j], rw_w_o[j])
        elif t == 1:
            m = swa_sink_mix(hn, cos, sin, sw_w_qkv[j], sw_b_qkv[j], sw_sinks[j],
                             sw_w_o[j], sw_b_o[j])
        elif t == 2:
            m = sgu_chunk_mix(hn, sg_w_in[j], sg_b_in[j], sg_ln_g[j], sg_ln_b[j],
                              sg_w_s[j], sg_b_s[j], sg_w_o[j], sg_b_o[j])
        else:
            m = gla_mix(hn, gla_w_in[j], gla_w_a2[j], gla_b_a[j], gla_gn_g[j], gla_w_o[j])
        h = h + m
        h = h + swiglu(rmsnorm(h, norm_ffn[i]), ffn_w_in[i], ffn_w_out[i])
    return rmsnorm(h, norm_final)
```

```cpp
#define OWN_BARRIER 0
#define SWT 0
#define GT 0
#include <hip/hip_runtime.h>
#include <hip/hip_cooperative_groups.h>
#include <cstdio>
namespace cg = cooperative_groups;

#define LAS __attribute__((address_space(3)))
typedef unsigned short bf16_t;
typedef short bf16x8 __attribute__((ext_vector_type(8)));
typedef float f32x4 __attribute__((ext_vector_type(4)));
typedef float f32x2 __attribute__((ext_vector_type(2)));
typedef unsigned u32x4 __attribute__((ext_vector_type(4)));
typedef unsigned u32x2 __attribute__((ext_vector_type(2)));

constexpr int MTOK = 32768, DM = 1024, SEQ = 4096, NB = 8, FFH = 2816;
constexpr float EPS = 1e-5f;
constexpr int NTHR = 512;
constexpr int LDS_BYTES = 147456;

constexpr size_t W_FFN_IN = 0;
constexpr size_t W_FFN_OUT = W_FFN_IN + (size_t)4 * 5632 * 1024 * 2;
constexpr size_t W_RKV = W_FFN_OUT + (size_t)4 * 1024 * 2816 * 2;
constexpr size_t W_L1 = W_RKV + (size_t)3 * 1024 * 1024 * 2;
constexpr size_t W_L2 = W_L1 + (size_t)256 * 2048 * 2;
constexpr size_t W_RWO = W_L2 + (size_t)3072 * 256 * 2;
constexpr size_t W_QKV = W_RWO + (size_t)1024 * 1024 * 2;
constexpr size_t W_SWO = W_QKV + (size_t)1280 * 1024 * 2;
constexpr size_t W_SGIN = W_SWO + (size_t)1024 * 1024 * 2;
constexpr size_t W_SGO = W_SGIN + (size_t)4096 * 1024 * 2;
constexpr size_t W_SGS = W_SGO + (size_t)1024 * 2048 * 2;
constexpr size_t W_GLIN = W_SGS + (size_t)16 * 128 * 128 * 2;
constexpr size_t W_GLO = W_GLIN + (size_t)3328 * 1024 * 2;
constexpr size_t SLOT0 = W_GLO + (size_t)1024 * 1024 * 2;
constexpr size_t SLOT = (size_t)64 * 1024 * 1024 + 65536;
constexpr size_t TAIL = SLOT0 + 6 * SLOT;
constexpr size_t T_COS = TAIL;
constexpr size_t T_SIN = T_COS + (size_t)MTOK * 32 * 4;
constexpr size_t T_STATS = T_SIN + (size_t)MTOK * 32 * 4;
constexpr size_t T_GDC = T_STATS + (size_t)MTOK * 2 * 4;
constexpr size_t T_BAR = T_GDC + (size_t)2048 * 128 * 4;
constexpr size_t T_STP = T_BAR + 16384;
constexpr size_t WS_END = T_STP + (size_t)MTOK * 64 * 4;
static_assert(WS_END <= (size_t)536870912, "workspace overflow");
#define SLOTP(i) (ws + SLOT0 + (size_t)(i) * SLOT)

struct Params { const float* in[41]; float* out; unsigned char* ws; int ph_lo, ph_hi; };

typedef __bf16 bf16x2_t __attribute__((ext_vector_type(2)));
__device__ __forceinline__ unsigned pk2(float lo, float hi) { const f32x2 v = {lo, hi}; const bf16x2_t b = __builtin_convertvector(v, bf16x2_t); return __builtin_bit_cast(unsigned, b); }
__device__ __forceinline__ float bflo(unsigned w) { return __uint_as_float(w << 16); }
__device__ __forceinline__ float bfhi(unsigned w) { return __uint_as_float(w & 0xffff0000u); }
__device__ __forceinline__ float bf2f(bf16_t b) { return __uint_as_float(((unsigned)b) << 16); }
__device__ __forceinline__ bf16_t f2bf(float f) { return (bf16_t)(pk2(f, 0.f) & 0xffffu); }
__device__ __forceinline__ u32x2 pk4(f32x4 v) { u32x2 w; w.x = pk2(v[0], v[1]); w.y = pk2(v[2], v[3]); return w; }
__device__ __forceinline__ f32x4 unpk4(u32x2 w) { return (f32x4){bflo(w.x), bfhi(w.x), bflo(w.y), bfhi(w.y)}; }
template <int CTRL> __device__ __forceinline__ float dppmov(float x) { return __builtin_bit_cast(float, __builtin_amdgcn_mov_dpp(__builtin_bit_cast(int, x), CTRL, 0xf, 0xf, true)); }
__device__ __forceinline__ float sum16(float x) { x += dppmov<0xB1>(x); x += dppmov<0x4E>(x); x += dppmov<0x141>(x); x += dppmov<0x128>(x); return x; }
__device__ __forceinline__ float max16(float x) { x = fmaxf(x, dppmov<0xB1>(x)); x = fmaxf(x, dppmov<0x4E>(x)); x = fmaxf(x, dppmov<0x141>(x)); x = fmaxf(x, dppmov<0x128>(x)); return x; }
__device__ __forceinline__ float dsum16(float x) { return sum16(x); }
__device__ __forceinline__ float xrow_sum(float x) {
    auto s = __builtin_amdgcn_permlane16_swap(__float_as_uint(x), __float_as_uint(x), false, false);
    x = __uint_as_float(s[0]) + __uint_as_float(s[1]);
    auto t = __builtin_amdgcn_permlane32_swap(__float_as_uint(x), __float_as_uint(x), false, false);
    return __uint_as_float(t[0]) + __uint_as_float(t[1]);
}
__device__ __forceinline__ float wave_sum(float v) { return xrow_sum(sum16(v)); }
__device__ __forceinline__ float sigmoidf_(float x) { return __builtin_amdgcn_rcpf(1.f + __expf(-x)); }
__device__ __forceinline__ float softplusf_(float x) { return fmaxf(x, 0.f) + __logf(1.f + __expf(-fabsf(x))); }
__device__ __forceinline__ f32x2 gelu_pk(f32x2 v) {
    const f32x2 av = __builtin_elementwise_abs(v), d = av * 0.2316418882f + 1.0f;
    f32x2 t; t.x = __builtin_amdgcn_rcpf(d.x); t.y = __builtin_amdgcn_rcpf(d.y);
    f32x2 q = t * 0.5307027145f + (-0.7265760135f); q = q * t + 0.7107068705f; q = q * t + (-0.142248368f); q = q * t + 0.127414796f; q = q * t;
    const f32x2 s = (v * v) * (-0.72134752044f);
    f32x2 e; e.x = __builtin_amdgcn_exp2f(s.x); e.y = __builtin_amdgcn_exp2f(s.y);
    const f32x2 m = v * (q * e), r = v - m;
    f32x2 o; o.x = v.x < 0.f ? m.x : r.x; o.y = v.y < 0.f ? m.y : r.y; return o;
}
__device__ __forceinline__ f32x4 mma16(const LAS bf16_t* a, const LAS bf16_t* b, f32x4 c) {
    const bf16x8 av = *(const LAS bf16x8*)a; const bf16x8 bv = *(const LAS bf16x8*)b;
    return __builtin_amdgcn_mfma_f32_16x16x32_bf16(av, bv, c, 0, 0, 0);
}

constexpr int PTAB_OFF = 146944;
__device__ __forceinline__ const float* inp(const LAS unsigned long long* t, int i) {
    const unsigned long long v = t[i]; const unsigned lo = __builtin_amdgcn_readfirstlane((unsigned)v), hi = __builtin_amdgcn_readfirstlane((unsigned)(v >> 32));
    return (const float*)(((unsigned long long)hi << 32) | lo);
}
namespace pg8 {
constexpr int BM = 256, BK = 64, HALF = 128, HTB = HALF * BK * 2, NXCD = 8, WGM = 8;
__device__ __forceinline__ int lds_byte(int r, int c) { const int st = (r >> 4) * 2 + (c >> 5), rr = r & 15, cc = c & 31, ob = rr * 64 + cc * 2; return st * 1024 + (ob ^ (((ob >> 9) & 1) << 5)); }
__device__ __forceinline__ void stage_rc(int b, int& R, int& C) { const int st = b / 1024, sb = b % 1024, swz = sb ^ (((sb >> 9) & 1) << 5); R = (st >> 1) * 16 + swz / 64; C = (st & 1) * 32 + (swz % 64) / 2; }
struct Unit { int pm, pn; };
struct Gemm { const bf16_t* A; const bf16_t* Bt; int M, N, K, lda, gap, mode; };
struct StaticOrder {
    int nM, nN, nwg, G, c, mode;
    __device__ void init(int M, int N, int G_, int c_, int mode_) { nM = M / BM; nN = N / BM; nwg = nM * nN; G = G_; c = c_; mode = (mode_ == 1 && G_ == 256 && nwg == 512) ? 1 : 0; }
    __device__ bool next(int i, Unit& u) const {
        int wgid;
        if (mode == 1) {
            if (c >= 128) { if (i >= 3) return false; wgid = (c - 128) * 3 + i; } else { if (i >= 1) return false; wgid = 384 + c; }
        } else {
            const long L = (long)i * G + c; if (L >= nwg) return false;
            wgid = (int)L; { const int q = nwg / NXCD, r = nwg % NXCD, xcd = wgid % NXCD, off = wgid / NXCD; wgid = (xcd < r ? xcd * (q + 1) : r * (q + 1) + (xcd - r) * q) + off; }
        }
        const int nig = WGM * nN, gid = wgid / nig, fm = gid * WGM, gsz = (nM - fm) < WGM ? (nM - fm) : WGM;
        u.pm = fm + ((wgid % nig) % gsz); u.pn = (wgid % nig) / gsz; return true;
    }
};

template <class Epi>
__device__ __forceinline__ void gemm_phase(const int tid_l, const int bid_l, LAS unsigned char* lds, const Gemm g, const Epi& E) {
    StaticOrder S; S.init(g.M, g.N, (int)gridDim.x, bid_l, g.mode);
    const int tid = tid_l, wid = __builtin_amdgcn_readfirstlane(tid >> 6), lane = tid & 63, wr = wid >> 2, wc = wid & 3, fr = lane & 15, fq = lane >> 4;
    const int K = g.K, nt = K / BK, lda = g.lda;
    unsigned voffA[2], voffB[2];
#pragma unroll
    for (int i = 0; i < 2; ++i) { int R, C; stage_rc(tid * 16 + i * 8192, R, C);
        voffA[i] = (unsigned)(R * lda + C) * 2u; voffB[i] = (unsigned)(R * K + C) * 2u; }
    const size_t kstep = (size_t)(BK * 2);
    const size_t hstepA = (size_t)HALF * lda * 2, hstepB = (size_t)HALF * K * 2;
    const size_t tstepB = 2 * hstepB;
    const unsigned ldsw = (unsigned)wid * 1024u;
    const int aoff = lds_byte(wr * 64 + fr, fq * 8), boff = lds_byte(wc * 32 + fr, fq * 8);
#define PG8_ABASE(pm) ((const char*)g.A + ((size_t)(pm) * 256 + (size_t)((pm) >> 4) * g.gap) * (size_t)lda * 2)
#define PG8_SA(b, h) (((b) * 2 + (h)) * HTB)
#define PG8_SB(b, h) ((4 + (b) * 2 + (h)) * HTB)
#define PG8_STAGE(bufoff, gbase, voff) do { _Pragma("unroll") for (int _i = 0; _i < 2; ++_i) \
        __builtin_amdgcn_global_load_lds((const unsigned*)((const char*)(gbase) + (voff)[_i]), (LAS unsigned*)(lds + (bufoff) + ldsw + _i * 8192), 16, 0, 0); } while (0)
#define PG8_LDA(dst, b, h) do { _Pragma("unroll") for (int m = 0; m < 4; ++m) _Pragma("unroll") for (int k = 0; k < 2; ++k) dst[m][k] = *(const LAS bf16x8*)(lds + PG8_SA(b, h) + aoff + m * 2048 + k * 1024); } while (0)
#define PG8_LDB(dst, b, h) do { _Pragma("unroll") for (int n = 0; n < 2; ++n) _Pragma("unroll") for (int k = 0; k < 2; ++k) dst[n][k] = *(const LAS bf16x8*)(lds + PG8_SB(b, h) + boff + n * 2048 + k * 1024); } while (0)
#define PG8_MMA(ai, bj, At, Bt) do { __builtin_amdgcn_s_setprio(1); _Pragma("unroll") for (int m = 0; m < 4; ++m) _Pragma("unroll") for (int n = 0; n < 2; ++n) _Pragma("unroll") for (int k = 0; k < 2; ++k) \
        acc[ai][bj][m][n] = __builtin_amdgcn_mfma_f32_16x16x32_bf16(Bt[n][k], At[m][k], acc[ai][bj][m][n], 0, 0, 0); __builtin_amdgcn_s_setprio(0); } while (0)
#define PG8_WAIT_V(n) asm volatile("s_waitcnt vmcnt(" #n ")" ::: "memory")
#define PG8_WAIT_L(n) asm volatile("s_waitcnt lgkmcnt(" #n ")" ::: "memory")
#define PG8_BAR __builtin_amdgcn_s_barrier()
#define PG8_SCHED __builtin_amdgcn_sched_barrier(0)
    Unit cur, nxt; int ui = 0;
    if (!S.next(0, cur)) return;
    f32x4 acc[2][2][4][2];
#pragma unroll
    for (int a = 0; a < 2; ++a)
#pragma unroll
        for (int b = 0; b < 2; ++b)
#pragma unroll
            for (int m = 0; m < 4; ++m)
#pragma unroll
                for (int n = 0; n < 2; ++n) acc[a][b][m][n] = (f32x4){0.f, 0.f, 0.f, 0.f};
    bf16x8 At[4][2], B0[2][2], B1[2][2];
    const char* cA = PG8_ABASE(cur.pm); const char* cB = (const char*)g.Bt + (size_t)cur.pn * tstepB;
    PG8_STAGE(PG8_SB(0, 0), cB, voffB); PG8_STAGE(PG8_SA(0, 0), cA, voffA); PG8_STAGE(PG8_SB(0, 1), cB + hstepB, voffB); PG8_STAGE(PG8_SA(0, 1), cA + hstepA, voffA);
    if (wr == 1) PG8_BAR;
    PG8_WAIT_V(4); PG8_BAR;
    PG8_STAGE(PG8_SB(1, 0), cB + kstep, voffB); PG8_STAGE(PG8_SA(1, 0), cA + kstep, voffA); PG8_STAGE(PG8_SB(1, 1), cB + hstepB + kstep, voffB);
    PG8_WAIT_V(6); PG8_BAR;
    for (;;) {
        const bool has_next = S.next(ui + 1, nxt);
        const char* nA = has_next ? PG8_ABASE(nxt.pm) : cA; const char* nB = has_next ? (const char*)g.Bt + (size_t)nxt.pn * tstepB : cB;
        for (int t = 0; t < nt; t += 2) {
            const bool last = (t == nt - 2);
            const char* a1 = cA + (size_t)(t + 1) * kstep;
            const char* a2 = last ? nA : cA + (size_t)(t + 2) * kstep; const char* b2 = last ? nB : cB + (size_t)(t + 2) * kstep;
            const char* a3 = a2 + kstep; const char* b3 = b2 + kstep;
            PG8_LDB(B0, 0, 0); PG8_SCHED; PG8_LDA(At, 0, 0); PG8_STAGE(PG8_SA(1, 1), a1 + hstepA, voffA);
            PG8_WAIT_L(8); PG8_BAR; PG8_WAIT_L(0); PG8_MMA(0, 0, At, B0); PG8_BAR; PG8_SCHED;
            PG8_LDB(B1, 0, 1); PG8_STAGE(PG8_SB(0, 0), b2, voffB);
            PG8_BAR; PG8_WAIT_L(0); PG8_MMA(0, 1, At, B1); PG8_BAR;
            PG8_LDA(At, 0, 1); PG8_STAGE(PG8_SA(0, 0), a2, voffA);
            PG8_BAR; PG8_WAIT_L(0); PG8_MMA(1, 0, At, B0); PG8_BAR; PG8_SCHED;
            PG8_STAGE(PG8_SB(0, 1), b2 + hstepB, voffB);
            PG8_WAIT_V(6); PG8_BAR; PG8_MMA(1, 1, At, B1); PG8_BAR;
            PG8_LDB(B0, 1, 0); PG8_SCHED; PG8_LDA(At, 1, 0); PG8_STAGE(PG8_SA(0, 1), a2 + hstepA, voffA);
            PG8_WAIT_L(8); PG8_BAR; PG8_WAIT_L(0); PG8_MMA(0, 0, At, B0); PG8_BAR; PG8_SCHED;
            PG8_LDB(B1, 1, 1); PG8_STAGE(PG8_SB(1, 0), b3, voffB);
            PG8_BAR; PG8_WAIT_L(0); PG8_MMA(0, 1, At, B1); PG8_BAR;
            PG8_LDA(At, 1, 1); PG8_STAGE(PG8_SA(1, 0), a3, voffA);
            PG8_BAR; PG8_WAIT_L(0); PG8_MMA(1, 0, At, B0); PG8_BAR; PG8_SCHED;
            PG8_STAGE(PG8_SB(1, 1), b3 + hstepB, voffB);
            PG8_WAIT_V(6); PG8_BAR; PG8_MMA(1, 1, At, B1); PG8_BAR;
        }
        E(acc, cur, wr, wc, fr, fq);
        if (!has_next) break;
#pragma unroll
        for (int a = 0; a < 2; ++a)
#pragma unroll
            for (int b = 0; b < 2; ++b)
#pragma unroll
                for (int m = 0; m < 4; ++m)
#pragma unroll
                    for (int n = 0; n < 2; ++n) acc[a][b][m][n] = (f32x4){0.f, 0.f, 0.f, 0.f};
        cur = nxt; cA = nA; cB = nB; ++ui;
    }
    PG8_WAIT_V(0);
    if (wr == 0) PG8_BAR;
    PG8_BAR;
#undef PG8_ABASE
#undef PG8_SA
#undef PG8_SB
#undef PG8_STAGE
#undef PG8_LDA
#undef PG8_LDB
#undef PG8_MMA
#undef PG8_WAIT_V
#undef PG8_WAIT_L
#undef PG8_BAR
#undef PG8_SCHED
}
}
using pg8::Unit; using pg8::Gemm;

#define EPI_SIG const f32x4 (&acc)[2][2][4][2], const Unit& u, int wr, int wc, int fr, int fq
#define EPI_LOOP_AM _Pragma("unroll") for (int ai = 0; ai < 2; ++ai) _Pragma("unroll") for (int m = 0; m < 4; ++m)
#define EPI_LOOP_BN _Pragma("unroll") for (int bj = 0; bj < 2; ++bj) _Pragma("unroll") for (int n = 0; n < 2; ++n)
#define EPI_ROW (u.pm * 256 + ai * 128 + wr * 64 + m * 16 + fr)
#define EPI_COL (u.pn * 256 + bj * 128 + wc * 32 + n * 16 + 4 * fq)

struct EpiBf16 {
    bf16_t* O; int ldc;
    __device__ __forceinline__ void operator()(EPI_SIG) const {
        EPI_LOOP_AM { const size_t ro = (size_t)EPI_ROW * ldc;
#pragma unroll
            for (int bj = 0; bj < 2; ++bj) { const int c = u.pn * 256 + bj * 128 + wc * 32 + 8 * fq; const u32x2 lo = pk4(acc[ai][bj][m][0]), hi = pk4(acc[ai][bj][m][1]);
                *(u32x4*)(O + ro + c) = (u32x4){lo.x, lo.y, hi.x, hi.y}; }
            asm volatile("" ::: "memory"); }
    }
};
struct EpiLora1 {
    bf16_t* O;
    __device__ __forceinline__ void operator()(EPI_SIG) const {
        EPI_LOOP_AM { const size_t ro = (size_t)EPI_ROW * 256; EPI_LOOP_BN { f32x4 v = acc[ai][bj][m][n];
            if (bj == 1) { for (int i = 0; i < 4; ++i) v[i] = sigmoidf_(v[i]); }
            else if (wc < 2) { for (int i = 0; i < 4; ++i) v[i] = 1.f - 2.f / (1.f + __expf(2.f * v[i])); }
            *(u32x2*)(O + ro + EPI_COL) = pk4(v); } asm volatile("" ::: "memory"); }
    }
};
struct EpiLora2 {
    float* Dd; bf16_t* Aa; bf16_t* Gg; const float* w0; const float* a0;
    __device__ __forceinline__ void operator()(EPI_SIG) const {
        const int sect = u.pn >> 2;
        if (sect == 0) {
            EPI_LOOP_AM { const size_t ro = (size_t)EPI_ROW * 1024; EPI_LOOP_BN { const int c = EPI_COL & 1023; f32x4 v = acc[ai][bj][m][n] + *(const f32x4*)(w0 + c);
#pragma unroll
                for (int i = 0; i < 4; ++i) { const float w = -softplusf_(-v[i]) - 0.5f; v[i] = __expf(-__expf(w)); }
                *(f32x4*)(Dd + ro + c) = v; asm volatile("" ::: "memory"); } }
        } else if (sect == 1) {
            EPI_LOOP_AM { const size_t ro = (size_t)EPI_ROW * 1024; EPI_LOOP_BN { const int c = EPI_COL & 1023; f32x4 v = acc[ai][bj][m][n] + *(const f32x4*)(a0 + c);
#pragma unroll
                for (int i = 0; i < 4; ++i) v[i] = sigmoidf_(v[i]);
                *(u32x2*)(Aa + ro + c) = pk4(v); asm volatile("" ::: "memory"); } }
        } else {
            EPI_LOOP_AM { const size_t ro = (size_t)EPI_ROW * 1024; EPI_LOOP_BN { const int c = EPI_COL & 1023; *(u32x2*)(Gg + ro + c) = pk4(acc[ai][bj][m][n]); } asm volatile("" ::: "memory"); }
        }
    }
};
struct EpiResid {
    const float* hin; float* hout; const float* bias;
    __device__ __forceinline__ void operator()(EPI_SIG) const {
        EPI_LOOP_AM { const size_t ro = (size_t)EPI_ROW * 1024;
#pragma unroll
            for (int bj = 0; bj < 2; ++bj) { const int c = u.pn * 256 + bj * 128 + wc * 32 + 8 * fq;
                f32x4 v0 = acc[ai][bj][m][0] + *(const f32x4*)(hin + ro + c), v1 = acc[ai][bj][m][1] + *(const f32x4*)(hin + ro + c + 4);
                if (bias) { v0 = v0 + *(const f32x4*)(bias + c); v1 = v1 + *(const f32x4*)(bias + c + 4); }
                *(f32x4*)(hout + ro + c) = v0; *(f32x4*)(hout + ro + c + 4) = v1; }
            asm volatile("" ::: "memory"); }
    }
};
struct EpiSwiglu {
    bf16_t* H;
    __device__ __forceinline__ void operator()(EPI_SIG) const {
        EPI_LOOP_AM { const size_t ro = (size_t)EPI_ROW * FFH; const int c = u.pn * 128 + wc * 32 + 8 * fq; f32x4 v[2];
#pragma unroll
            for (int n = 0; n < 2; ++n) { const f32x4 g = acc[ai][0][m][n], up = acc[ai][1][m][n];
#pragma unroll
                for (int i = 0; i < 4; ++i) v[n][i] = g[i] * __builtin_amdgcn_rcpf(1.f + __expf(-g[i])) * up[i]; }
            const u32x2 lo = pk4(v[0]), hi = pk4(v[1]);
            *(u32x4*)(H + ro + c) = (u32x4){lo.x, lo.y, hi.x, hi.y}; asm volatile("" ::: "memory"); }
    }
};
struct EpiQKV {
    bf16_t* Q; bf16_t* Kb; bf16_t* Vb; const float* bias; const float* cosT; const float* sinT;
    __device__ __forceinline__ void operator()(EPI_SIG) const {
        EPI_LOOP_AM { const int row = EPI_ROW;
#pragma unroll
            for (int n = 0; n < 2; ++n) { const int d1 = n * 16 + 4 * fq; const f32x4 t1r = acc[ai][0][m][n], t2r = acc[ai][1][m][n];
                if (u.pn < 4 || wc < 2) {
                    const bool isq = u.pn < 4; const int head = isq ? 4 * u.pn + wc : wc; const int c1 = head * 64 + d1; const int bo = isq ? c1 : 1024 + c1;
                    const f32x4 t1 = t1r + *(const f32x4*)(bias + bo), t2 = t2r + *(const f32x4*)(bias + bo + 32);
                    const f32x4 cs = *(const f32x4*)(cosT + (size_t)row * 32 + d1), sn = *(const f32x4*)(sinT + (size_t)row * 32 + d1);
                    const f32x4 o1 = t1 * cs - t2 * sn, o2 = t2 * cs + t1 * sn;
                    bf16_t* dst = isq ? Q + (size_t)row * 1024 + c1 : Kb + (size_t)row * 128 + c1;
                    *(u32x2*)dst = pk4(o1); *(u32x2*)(dst + 32) = pk4(o2);
                } else {
                    const int j = (wc - 2) * 32 + d1;
                    const f32x4 v0 = t1r + *(const f32x4*)(bias + 1152 + j), v1 = t2r + *(const f32x4*)(bias + 1216 + j);
                    *(u32x2*)(Vb + (size_t)row * 128 + j) = pk4(v0); *(u32x2*)(Vb + (size_t)row * 128 + 64 + j) = pk4(v1);
                } } asm volatile("" ::: "memory"); }
    }
};
struct EpiSGUin {
    bf16_t* U; bf16_t* V; const float* bias; float* stats;
    __device__ __forceinline__ void operator()(EPI_SIG) const {
        const bool isv = u.pn >= 8;
        EPI_LOOP_AM { const int row = EPI_ROW; float s1 = 0.f, s2 = 0.f;
#pragma unroll
            for (int bj = 0; bj < 2; ++bj) { const int c = u.pn * 256 + bj * 128 + wc * 32 + 8 * fq; f32x4 v[2];
#pragma unroll
                for (int n = 0; n < 2; ++n) { const f32x4 t = acc[ai][bj][m][n] + *(const f32x4*)(bias + c + 4 * n);
                    const f32x2 a = gelu_pk((f32x2){t[0], t[1]}), b = gelu_pk((f32x2){t[2], t[3]}); v[n] = (f32x4){a.x, a.y, b.x, b.y};
                    s1 += (v[n][0] + v[n][1]) + (v[n][2] + v[n][3]); s2 += (v[n][0] * v[n][0] + v[n][1] * v[n][1]) + (v[n][2] * v[n][2] + v[n][3] * v[n][3]); }
                const u32x2 lo = pk4(v[0]), hi = pk4(v[1]); const u32x4 w4 = {lo.x, lo.y, hi.x, hi.y};
                if (isv) *(u32x4*)(V + (size_t)row * 2048 + (c - 2048)) = w4; else *(u32x4*)(U + (size_t)row * 2048 + c) = w4; }
            if (isv) { s1 = xrow_sum(s1); s2 = xrow_sum(s2);
                if (fq == 0) *(f32x2*)(stats + (size_t)row * 64 + (u.pn - 8) * 8 + wc * 2) = (f32x2){s1, s2}; } asm volatile("" ::: "memory"); }
    }
};

template <class F>
__device__ __forceinline__ void cvt_tiles(const int tid_l, const int bid_l, bf16_t* dst, int N, int K, F f, LAS float* scr, int rot) {
    const int tid = tid_l, ntn = N / 64, ntk = K / 64, ntile = ntn * ntk;
    const int i = tid & 63, j = tid >> 6, nn = tid >> 3, c = tid & 7;
    for (int t = (int)((bid_l + rot) % gridDim.x); t < ntile; t += gridDim.x) {
        const int n0 = (t % ntn) * 64, k0 = (t / ntn) * 64;
#pragma unroll
        for (int pp = 0; pp < 8; ++pp) { const int kk = pp * 8 + j; scr[kk * 65 + i] = f(n0 + i, k0 + kk); }
        __syncthreads();
        const LAS float* s = scr + (8 * c) * 65 + nn;
        u32x4 o; o.x = pk2(s[0], s[65]); o.y = pk2(s[130], s[195]); o.z = pk2(s[260], s[325]); o.w = pk2(s[390], s[455]);
        *(u32x4*)(dst + (size_t)(n0 + nn) * K + k0 + 8 * c) = o;
        __syncthreads();
    }
}
__device__ __forceinline__ int perm32(int rho) { const int n = rho >> 4, i = rho & 15; return 8 * (i >> 2) + 4 * n + (i & 3); }
struct FPlain { const float* W; int N; __device__ __forceinline__ float operator()(int n, int k) const { return W[(size_t)k * N + n]; } };
struct FPlainP { const float* W; int N; __device__ __forceinline__ float operator()(int n, int k) const { return W[(size_t)k * N + (n & ~31) + perm32(n & 31)]; } };
struct FFfnIn { const float* W; __device__ __forceinline__ float operator()(int n, int k) const { const int pn = n >> 8, s = n & 255, j = s & 127; const int col = (s < 128 ? 0 : 2816) + 128 * pn + (j & ~31) + perm32(j & 31); return W[(size_t)k * 5632 + col]; } };
struct FLora1 { const float *w1, *a1, *g1, *mu; __device__ __forceinline__ float operator()(int n, int k) const {
    const float* W; int ld, col, c; if (n < 64) { W = w1; ld = 64; col = n; c = 1; } else if (n < 128) { W = a1; ld = 64; col = n - 64; c = 4; } else { W = g1; ld = 128; col = n - 128; c = 5; }
    const int kk = k & 1023; const float m = mu[c * 1024 + kk]; return (k < 1024 ? m : 1.f - m) * W[(size_t)kk * ld + col]; } };
struct FLora2 { const float *w2, *a2, *g2; __device__ __forceinline__ float operator()(int n, int k) const {
    if (n < 1024) return k < 64 ? w2[(size_t)k * 1024 + n] : 0.f;
    if (n < 2048) return (k >= 64 && k < 128) ? a2[(size_t)(k - 64) * 1024 + (n - 1024)] : 0.f;
    return k >= 128 ? g2[(size_t)(k - 128) * 1024 + (n - 2048)] : 0.f; } };
struct FQkv { const float* W; __device__ __forceinline__ float operator()(int n, int k) const {
    const int pn = n >> 8, s = n & 255, hi = s >> 7, j = s & 127; int col;
    if (pn < 4) col = (4 * pn + (j >> 5)) * 64 + 32 * hi + (j & 31);
    else if (j < 64) col = 1024 + (j >> 5) * 64 + 32 * hi + (j & 31);
    else col = 1152 + 64 * hi + (j - 64);
    return W[(size_t)k * 1280 + col]; } };
struct FGlaIn { const float* W; __device__ __forceinline__ float operator()(int n, int k) const { const int c = (n & ~31) + perm32(n & 31); return c < 3088 ? W[(size_t)k * 3088 + c] : 0.f; } };

template <class F>
__device__ __forceinline__ void cvt_item_wave(bf16_t* dst, int N, int K, F f, LAS float* scr, int it, int lane) {
    const int nblk = N / 32, kb = it / nblk, nb = it - kb * nblk, k0 = 64 * kb, n0 = 32 * nb, c = lane & 7;
#pragma unroll 8
    for (int i = 0; i < 32; ++i) { const int kk = 2 * i + (lane >> 5); scr[kk * 33 + (lane & 31)] = f(n0 + (lane & 31), k0 + kk); }
    asm volatile("s_waitcnt lgkmcnt(0)" ::: "memory");
#pragma unroll
    for (int j = 0; j < 4; ++j) { const int n = (lane >> 3) + 8 * j; const LAS float* sp = scr + (8 * c) * 33 + n;
        u32x4 o; o.x = pk2(sp[0 * 33], sp[1 * 33]); o.y = pk2(sp[2 * 33], sp[3 * 33]); o.z = pk2(sp[4 * 33], sp[5 * 33]); o.w = pk2(sp[6 * 33], sp[7 * 33]);
        *(u32x4*)(dst + (size_t)(n0 + n) * K + k0 + 8 * c) = o; }
    asm volatile("s_waitcnt lgkmcnt(0)" ::: "memory");
}
struct CvtPend { bf16_t* dst; int K, n0, k0; float v[32]; };
template <class F>
__device__ __forceinline__ void cvt_issue(CvtPend& pd, bf16_t* dst, int N, int K, F f, int it, int lane) {
    const int nblk = N / 32, kb = it / nblk, nb = it - kb * nblk; pd.dst = dst; pd.K = K; pd.k0 = 64 * kb; pd.n0 = 32 * nb;
#pragma unroll
    for (int i = 0; i < 32; ++i) pd.v[i] = f(pd.n0 + (lane & 31), pd.k0 + 2 * i + (lane >> 5));
}
__device__ __forceinline__ void cvt_finish(const CvtPend& pd, LAS float* scr, int lane) {
    const int c = lane & 7;
#pragma unroll
    for (int i = 0; i < 32; ++i) scr[(2 * i + (lane >> 5)) * 33 + (lane & 31)] = pd.v[i];
    asm volatile("s_waitcnt lgkmcnt(0)" ::: "memory");
#pragma unroll
    for (int j = 0; j < 4; ++j) { const int n = (lane >> 3) + 8 * j; const LAS float* sp = scr + (8 * c) * 33 + n;
        u32x4 o; o.x = pk2(sp[0 * 33], sp[1 * 33]); o.y = pk2(sp[2 * 33], sp[3 * 33]); o.z = pk2(sp[4 * 33], sp[5 * 33]); o.w = pk2(sp[6 * 33], sp[7 * 33]);
        *(u32x4*)(pd.dst + (size_t)(pd.n0 + n) * pd.K + pd.k0 + 8 * c) = o; }
    asm volatile("s_waitcnt lgkmcnt(0)" ::: "memory");
}
constexpr int DEF_FFN = 2816 + 1408, DEF_TOTAL = 4 * DEF_FFN + 640 + 512 + 2048 + 1024 + 1664 + 512;
__device__ __forceinline__ void cvt_deferred_item(const LAS unsigned long long* ptab, unsigned char* ws, LAS float* scr, int g, int lane) {
    int r = g;
    if (r < 4 * DEF_FFN) { const int l = r / DEF_FFN; r -= l * DEF_FFN;
        if (r < 2816) cvt_item_wave((bf16_t*)(ws + W_FFN_IN) + (size_t)l * 5632 * 1024, 5632, 1024, FFfnIn{inp(ptab, 4) + (size_t)l * 1024 * 5632}, scr, r, lane);
        else cvt_item_wave((bf16_t*)(ws + W_FFN_OUT) + (size_t)l * 1024 * 2816, 1024, 2816, FPlainP{inp(ptab, 5) + (size_t)l * 2816 * 1024, 1024}, scr, r - 2816, lane);
        return; }
    r -= 4 * DEF_FFN;
    if (r < 640) { cvt_item_wave((bf16_t*)(ws + W_QKV), 1280, 1024, FQkv{inp(ptab, 23)}, scr, r, lane); return; } r -= 640;
    if (r < 512) { cvt_item_wave((bf16_t*)(ws + W_SWO), 1024, 1024, FPlainP{inp(ptab, 26), 1024}, scr, r, lane); return; } r -= 512;
    if (r < 2048) { cvt_item_wave((bf16_t*)(ws + W_SGIN), 4096, 1024, FPlainP{inp(ptab, 28), 4096}, scr, r, lane); return; } r -= 2048;
    if (r < 1024) { cvt_item_wave((bf16_t*)(ws + W_SGO), 1024, 2048, FPlainP{inp(ptab, 34), 1024}, scr, r, lane); return; } r -= 1024;
    if (r < 1664) { cvt_item_wave((bf16_t*)(ws + W_GLIN), 3328, 1024, FGlaIn{inp(ptab, 36)}, scr, r, lane); return; } r -= 1664;
    if (r < 512) cvt_item_wave((bf16_t*)(ws + W_GLO), 1024, 1024, FPlainP{inp(ptab, 40), 1024}, scr, r, lane);
}
__device__ __forceinline__ void cvt_deferred_issue(CvtPend& pd, const LAS unsigned long long* ptab, unsigned char* ws, int g, int lane) {
    int r = g;
    if (r < 4 * DEF_FFN) { const int l = r / DEF_FFN; r -= l * DEF_FFN;
        if (r < 2816) cvt_issue(pd, (bf16_t*)(ws + W_FFN_IN) + (size_t)l * 5632 * 1024, 5632, 1024, FFfnIn{inp(ptab, 4) + (size_t)l * 1024 * 5632}, r, lane);
        else cvt_issue(pd, (bf16_t*)(ws + W_FFN_OUT) + (size_t)l * 1024 * 2816, 1024, 2816, FPlainP{inp(ptab, 5) + (size_t)l * 2816 * 1024, 1024}, r - 2816, lane);
        return; }
    r -= 4 * DEF_FFN;
    if (r < 640) { cvt_issue(pd, (bf16_t*)(ws + W_QKV), 1280, 1024, FQkv{inp(ptab, 23)}, r, lane); return; } r -= 640;
    if (r < 512) { cvt_issue(pd, (bf16_t*)(ws + W_SWO), 1024, 1024, FPlainP{inp(ptab, 26), 1024}, r, lane); return; } r -= 512;
    if (r < 2048) { cvt_issue(pd, (bf16_t*)(ws + W_SGIN), 4096, 1024, FPlainP{inp(ptab, 28), 4096}, r, lane); return; } r -= 2048;
    if (r < 1024) { cvt_issue(pd, (bf16_t*)(ws + W_SGO), 1024, 2048, FPlainP{inp(ptab, 34), 1024}, r, lane); return; } r -= 1024;
    if (r < 1664) { cvt_issue(pd, (bf16_t*)(ws + W_GLIN), 3328, 1024, FGlaIn{inp(ptab, 36)}, r, lane); return; } r -= 1664;
    if (r < 512) cvt_issue(pd, (bf16_t*)(ws + W_GLO), 1024, 1024, FPlainP{inp(ptab, 40), 1024}, r, lane);
}
__device__ __forceinline__ void phase_prep(const int tid_l, const int bid_l, const LAS unsigned long long* ptab, unsigned char* ws, LAS unsigned char* lds) {
    LAS float* scr = (LAS float*)lds;
    int rot = 0;
    for (int l = 0; l < 4; ++l) {
    }
    for (int c = 0; c < 3; ++c) { cvt_tiles(tid_l, bid_l, (bf16_t*)(ws + W_RKV) + (size_t)c * 1024 * 1024, 1024, 1024, FPlainP{inp(ptab, 8) + (size_t)c * 1024 * 1024, 1024}, scr, rot); }
    cvt_tiles(tid_l, bid_l, (bf16_t*)(ws + W_L1), 256, 2048, FLora1{inp(ptab, 10), inp(ptab, 13), inp(ptab, 15), inp(ptab, 7)}, scr, rot); rot += 128;
    cvt_tiles(tid_l, bid_l, (bf16_t*)(ws + W_L2), 3072, 256, FLora2{inp(ptab, 11), inp(ptab, 14), inp(ptab, 16)}, scr, rot); rot += 192;
    cvt_tiles(tid_l, bid_l, (bf16_t*)(ws + W_RWO), 1024, 1024, FPlainP{inp(ptab, 22), 1024}, scr, rot);
    const size_t gt = (size_t)bid_l * NTHR + tid_l, gn = (size_t)gridDim.x * NTHR;
    { bf16_t* d = (bf16_t*)(ws + W_SGS); const float* w = inp(ptab, 32);
      for (size_t i = gt; i < (size_t)16 * 128 * 128; i += gn) { const int s = (int)(i & 127), t = (int)((i >> 7) & 127); d[i] = f2bf(s <= t ? w[i] : 0.f); } }
    { float* ct = (float*)(ws + T_COS); float* st = (float*)(ws + T_SIN); const int* pos = (const int*)inp(ptab, 1);
      for (size_t i = gt; i < (size_t)MTOK * 32; i += gn) { const int d = (int)(i & 31); const float inv = powf(10000.f, -(float)(2 * d) / 64.f); const float ang = (float)pos[i >> 5] * inv; ct[i] = cosf(ang); st[i] = sinf(ang); } }
#ifdef ZERO_FILL
    { u32x4* z = (u32x4*)(ws + SLOT0); const size_t nz = (6 * SLOT) / 16; for (size_t i = gt; i < nz; i += gn) z[i] = (u32x4){0u, 0u, 0u, 0u};
      u32x4* zo = (u32x4*)inp(ptab, 41); for (size_t i = gt; i < (size_t)MTOK * 1024 / 4; i += gn) zo[i] = (u32x4){0u, 0u, 0u, 0u}; }
#endif
}

__device__ __forceinline__ void phase_norm(const int tid_l, const int bid_l, const float* h, const float* g, bf16_t* out) {
    const int lane = tid_l & 63, gw = bid_l * 8 + (tid_l >> 6), ngw = gridDim.x * 8;
    f32x4 gv[4];
#pragma unroll
    for (int j = 0; j < 4; ++j) gv[j] = *(const f32x4*)(g + 4 * lane + 256 * j);
    for (int row = 2 * gw; row < MTOK; row += 2 * ngw) {
        f32x4 v[2][4]; float ss[2] = {0.f, 0.f};
#pragma unroll
        for (int r = 0; r < 2; ++r)
#pragma unroll
            for (int j = 0; j < 4; ++j) v[r][j] = *(const f32x4*)(h + (size_t)(row + r) * 1024 + 4 * lane + 256 * j);
#pragma unroll
        for (int r = 0; r < 2; ++r)
#pragma unroll
            for (int j = 0; j < 4; ++j) ss[r] += (v[r][j][0] * v[r][j][0] + v[r][j][1] * v[r][j][1]) + (v[r][j][2] * v[r][j][2] + v[r][j][3] * v[r][j][3]);
#pragma unroll
        for (int r = 0; r < 2; ++r) { const float rstd = rsqrtf(wave_sum(ss[r]) * (1.f / 1024.f) + EPS);
#pragma unroll
            for (int j = 0; j < 4; ++j) *(u32x2*)(out + (size_t)(row + r) * 1024 + 4 * lane + 256 * j) = pk4(v[r][j] * rstd * gv[j]); }
    }
}
__device__ __forceinline__ void phase_final(const int tid_l, const int bid_l, float* h, const float* g) {
    const int lane = tid_l & 63, gw = bid_l * 8 + (tid_l >> 6), ngw = gridDim.x * 8;
    f32x4 gv[4];
#pragma unroll
    for (int j = 0; j < 4; ++j) gv[j] = *(const f32x4*)(g + 4 * lane + 256 * j);
    for (int row = 2 * gw; row < MTOK; row += 2 * ngw) {
        f32x4 v[2][4]; float ss[2] = {0.f, 0.f};
#pragma unroll
        for (int r = 0; r < 2; ++r)
#pragma unroll
            for (int j = 0; j < 4; ++j) v[r][j] = *(const f32x4*)(h + (size_t)(row + r) * 1024 + 4 * lane + 256 * j);
#pragma unroll
        for (int r = 0; r < 2; ++r)
#pragma unroll
            for (int j = 0; j < 4; ++j) ss[r] += (v[r][j][0] * v[r][j][0] + v[r][j][1] * v[r][j][1]) + (v[r][j][2] * v[r][j][2] + v[r][j][3] * v[r][j][3]);
#pragma unroll
        for (int r = 0; r < 2; ++r) { const float rstd = rsqrtf(wave_sum(ss[r]) * (1.f / 1024.f) + EPS);
#pragma unroll
            for (int j = 0; j < 4; ++j) *(f32x4*)(h + (size_t)(row + r) * 1024 + 4 * lane + 256 * j) = v[r][j] * rstd * gv[j]; }
    }
}
__device__ __forceinline__ void phase_rw_norm(const int tid_l, const int bid_l, const float* x, const float* g, const float* mu, bf16_t* hnG, bf16_t* xr, bf16_t* xk, bf16_t* xv) {
    const int lane = tid_l & 63, gw = bid_l * 8 + (tid_l >> 6), ngw = gridDim.x * 8;
    for (int row = gw; row < MTOK; row += ngw) {
        const int b = row >> 12, s = row & 4095;
        f32x4 v[4], pv[4]; float ss = 0.f, ps = 0.f;
#pragma unroll
        for (int j = 0; j < 4; ++j) { v[j] = *(const f32x4*)(x + (size_t)row * 1024 + 4 * lane + 256 * j); ss += (v[j][0] * v[j][0] + v[j][1] * v[j][1]) + (v[j][2] * v[j][2] + v[j][3] * v[j][3]);
            pv[j] = s > 0 ? *(const f32x4*)(x + (size_t)(row - 1) * 1024 + 4 * lane + 256 * j) : (f32x4){0.f, 0.f, 0.f, 0.f}; ps += (pv[j][0] * pv[j][0] + pv[j][1] * pv[j][1]) + (pv[j][2] * pv[j][2] + pv[j][3] * pv[j][3]); }
        const float rstd = rsqrtf(wave_sum(ss) * (1.f / 1024.f) + EPS), prstd = rsqrtf(wave_sum(ps) * (1.f / 1024.f) + EPS);
#pragma unroll
        for (int j = 0; j < 4; ++j) { const int c = 4 * lane + 256 * j; const f32x4 gv = *(const f32x4*)(g + c);
            const f32x4 hn = v[j] * rstd * gv, hp = pv[j] * prstd * gv, xx = hp - hn;
            *(u32x2*)(hnG + (size_t)(row + b + 1) * 1024 + c) = pk4(hn);
            if (s == 0) *(u32x2*)(hnG + (size_t)(row + b) * 1024 + c) = (u32x2){0u, 0u};
            *(u32x2*)(xr + (size_t)row * 1024 + c) = pk4(hn + xx * *(const f32x4*)(mu + 0 * 1024 + c));
            *(u32x2*)(xk + (size_t)row * 1024 + c) = pk4(hn + xx * *(const f32x4*)(mu + 2 * 1024 + c));
            *(u32x2*)(xv + (size_t)row * 1024 + c) = pk4(hn + xx * *(const f32x4*)(mu + 3 * 1024 + c)); }
    }
}

#ifndef SCAN_DPP
#define SCAN_DPP 0
#endif
__device__ __forceinline__ float scan_red(float x) { return SCAN_DPP ? dsum16(x) : sum16(x); }
__device__ __forceinline__ void phase_rw_scan(const int tid_l, const int bid_l, const bf16_t* R, const bf16_t* Kk, const bf16_t* V, const bf16_t* Aa, const float* Dd, const float* k_k, const float* k_a, bf16_t* Y, LAS unsigned char* lds, const LAS unsigned long long* ptab, unsigned char* ws) {
    LAS float* buf = (LAS float*)lds;
    LAS float* vbuf = (LAS float*)(lds + 81920);
    LAS float* ybuf = (LAS float*)(lds + 81920 + 8192);
    const int tid = tid_l, lane = tid & 63, w = __builtin_amdgcn_readfirstlane(tid >> 6), rp = lane >> 4, cl = lane & 15;
    const bool is_loader = w >= 4;
    const int lt = tid - 256, lj = (lt >> 4) & 15, lcg = lt & 15;
    LAS float* cscr = (LAS float*)(lds + 98304) + (w >= 4 ? (w - 4) : 0) * (64 * 33);
    const int dlw = bid_l * 4 + (w - 4), dstride = (int)gridDim.x * 4; bool defer = true;
    for (int item = bid_l; item < 256; item += gridDim.x) {
        const int b = item >> 5, h = (item >> 1) & 15, half = item & 1;
        const size_t colb = (size_t)h * 64 + 4 * lcg;
        f32x4 kkv = {0.f, 0.f, 0.f, 0.f}, kav = {0.f, 0.f, 0.f, 0.f};
        if (is_loader) { kkv = *(const f32x4*)(k_k + colb); kav = *(const f32x4*)(k_a + colb); }
        const int r0 = 8 * w + 2 * rp;
        f32x2 a01 = {0.f, 0.f}, a23 = {0.f, 0.f}, b01 = {0.f, 0.f}, b23 = {0.f, 0.f};
        u32x2 lr[2], lk[2], la[2], lv[2]; f32x4 ld[2];
        auto gload = [&](int c) {
#pragma unroll
            for (int q = 0; q < 2; ++q) { const size_t m = (size_t)b * 4096 + c * 32 + lj + 16 * q; const size_t o = m * 1024 + colb;
                lr[q] = *(const u32x2*)(R + o); lk[q] = *(const u32x2*)(Kk + o); la[q] = *(const u32x2*)(Aa + o); ld[q] = *(const f32x4*)(Dd + o);
                if (lcg < 8) lv[q] = *(const u32x2*)(V + m * 1024 + h * 64 + half * 32 + 4 * lcg); } };
        auto lstore = [&](int nbuf) {
#pragma unroll
            for (int q = 0; q < 2; ++q) { const int st = lj + 16 * q; const f32x4 r4 = unpk4(lr[q]), k4 = unpk4(lk[q]), a4 = unpk4(la[q]);
                const f32x4 kx = k4 * kkv; float ssq = (kx[0] * kx[0] + kx[1] * kx[1]) + (kx[2] * kx[2] + kx[3] * kx[3]); ssq = sum16(ssq);
                const f32x4 kk = kx * rsqrtf(fmaxf(ssq, 1e-24f)); const f32x4 nb = -(kk * a4); const f32x4 km = k4 * (1.f + (a4 - 1.f) * kav);
                LAS float* bp = buf + ((nbuf * 32 + st) * 5) * 64 + 4 * lcg;
                *(LAS f32x4*)(bp) = ld[q]; *(LAS f32x4*)(bp + 64) = kk; *(LAS f32x4*)(bp + 128) = nb; *(LAS f32x4*)(bp + 192) = km; *(LAS f32x4*)(bp + 256) = r4;
                if (lcg < 8) *(LAS f32x4*)(vbuf + (nbuf * 32 + st) * 32 + 4 * lcg) = unpk4(lv[q]); } };
        auto ycopy = [&](int c) {
#pragma unroll
            for (int q = 0; q < 2; ++q) if (lcg < 8) { const int st = lj + 16 * q; const size_t m = (size_t)b * 4096 + c * 32 + st; const f32x4 yv = *(const LAS f32x4*)(ybuf + ((c & 1) * 32 + st) * 32 + 4 * lcg);
                *(u32x2*)(Y + m * 1024 + h * 64 + half * 32 + 4 * lcg) = pk4(yv); } };
        __syncthreads();
        if (is_loader) { gload(0); lstore(0); }
        __syncthreads();
        for (int c = 0; c < 128; ++c) {
            if (is_loader) {
                if (c + 1 < 128) gload(c + 1);
                if (c > 0) ycopy(c - 1);
                const int dg = dlw + dstride * (c / 5); const bool ddo = defer && (c % 5) == 0 && dg < DEF_TOTAL;
                CvtPend pd;
                if (ddo) cvt_deferred_issue(pd, ptab, ws, dg, lane);
                if (c + 1 < 128) lstore((c + 1) & 1);
                if (ddo) cvt_finish(pd, cscr, lane);
            } else {
                const int cb = c & 1;
                const LAS float* bp0 = buf + (cb * 32 * 5) * 64 + 4 * cl; const LAS float* vp0 = vbuf + (cb * 32) * 32 + r0;
                f32x4 d4 = *(const LAS f32x4*)(bp0), kk4 = *(const LAS f32x4*)(bp0 + 64), nb4 = *(const LAS f32x4*)(bp0 + 128), km4 = *(const LAS f32x4*)(bp0 + 192), r4 = *(const LAS f32x4*)(bp0 + 256);
                f32x2 vv = *(const LAS f32x2*)(vp0);
#pragma unroll
                for (int jb = 0; jb < 32; jb += 16) {
                    f32x2 ysel = {0.f, 0.f};
#pragma unroll
                    for (int jj = 0; jj < 16; ++jj) {
                        const int j = jb + jj;
                        f32x4 d4n = d4, kk4n = kk4, nb4n = nb4, km4n = km4, r4n = r4; f32x2 vvn = vv;
                        if (j + 1 < 32) { const LAS float* bp = bp0 + (j + 1) * 320;
                            d4n = *(const LAS f32x4*)(bp); kk4n = *(const LAS f32x4*)(bp + 64); nb4n = *(const LAS f32x4*)(bp + 128); km4n = *(const LAS f32x4*)(bp + 192); r4n = *(const LAS f32x4*)(bp + 256);
                            vvn = *(const LAS f32x2*)(vp0 + (j + 1) * 32); }
                        const f32x2 d01 = {d4[0], d4[1]}, d23 = {d4[2], d4[3]}, k01 = {kk4[0], kk4[1]}, k23 = {kk4[2], kk4[3]}, n01 = {nb4[0], nb4[1]}, n23 = {nb4[2], nb4[3]};
                        const f32x2 m01 = {km4[0], km4[1]}, m23 = {km4[2], km4[3]}, q01 = {r4[0], r4[1]}, q23 = {r4[2], r4[3]};
                        f32x2 ta = a01 * k01 + a23 * k23, tb = b01 * k01 + b23 * k23;
                        const float sa0 = sum16(ta[0] + ta[1]), sa1 = sum16(tb[0] + tb[1]);
                        a01 = a01 * d01 + n01 * sa0 + m01 * vv[0]; a23 = a23 * d23 + n23 * sa0 + m23 * vv[0];
                        b01 = b01 * d01 + n01 * sa1 + m01 * vv[1]; b23 = b23 * d23 + n23 * sa1 + m23 * vv[1];
                        ta = a01 * q01 + a23 * q23; tb = b01 * q01 + b23 * q23;
                        const float y0 = sum16(ta[0] + ta[1]), y1 = sum16(tb[0] + tb[1]);
                        if (cl == jj) ysel = (f32x2){y0, y1};
                        d4 = d4n; kk4 = kk4n; nb4 = nb4n; km4 = km4n; r4 = r4n; vv = vvn;
                    }
                    *(LAS f32x2*)(ybuf + (cb * 32 + jb + cl) * 32 + r0) = ysel;
                }
            }
            __syncthreads();
        }
        if (is_loader) { ycopy(127); if (defer) for (int t = 26; dlw + dstride * t < DEF_TOTAL; ++t) cvt_deferred_item(ptab, ws, cscr, dlw + dstride * t, lane); }
        defer = false;
    }
}
__device__ __forceinline__ void phase_rw_post(const int tid_l, const int bid_l, const bf16_t* Y, const bf16_t* R, const bf16_t* Kk, const bf16_t* V, const bf16_t* Aa, const bf16_t* Gg,
                                              const float* k_a, const float* r_k, const float* gn_g, const float* gn_b, bf16_t* Z) {
    const size_t gt = (size_t)bid_l * NTHR + tid_l, gn = (size_t)gridDim.x * NTHR;
    for (size_t i = gt; i < (size_t)MTOK * 256; i += gn) {
        const size_t o = i * 4; const int c = (int)(o & 1023);
        const f32x4 y = unpk4(*(const u32x2*)(Y + o)), r = unpk4(*(const u32x2*)(R + o)), k = unpk4(*(const u32x2*)(Kk + o)), v = unpk4(*(const u32x2*)(V + o)), a = unpk4(*(const u32x2*)(Aa + o)), g = unpk4(*(const u32x2*)(Gg + o));
        const f32x4 km = k * (1.f + (a - 1.f) * *(const f32x4*)(k_a + c));
        const f32x4 rk = r * km * *(const f32x4*)(r_k + c);
        const float mean = sum16((y[0] + y[1]) + (y[2] + y[3])) * (1.f / 64.f);
        const f32x4 dy = y - mean;
        const float var = sum16((dy[0] * dy[0] + dy[1] * dy[1]) + (dy[2] * dy[2] + dy[3] * dy[3])) * (1.f / 64.f);
        const float bon = sum16((rk[0] + rk[1]) + (rk[2] + rk[3]));
        const f32x4 yn = dy * rsqrtf(var + 64e-5f) * *(const f32x4*)(gn_g + c) + *(const f32x4*)(gn_b + c);
        *(u32x2*)(Z + o) = pk4((yn + bon * v) * g);
    }
}

__device__ __forceinline__ u32x4 ld_coh(const bf16_t* p) {
    const unsigned long long* q = (const unsigned long long*)p;
    const unsigned long long a = __hip_atomic_load(q, __ATOMIC_RELAXED, __HIP_MEMORY_SCOPE_AGENT), b = __hip_atomic_load(q + 1, __ATOMIC_RELAXED, __HIP_MEMORY_SCOPE_AGENT);
    return (u32x4){(unsigned)a, (unsigned)(a >> 32), (unsigned)b, (unsigned)(b >> 32)};
}
__device__ __forceinline__ float ssum16(float v) {
#pragma unroll
    for (int o = 1; o < 16; o <<= 1) v += __shfl_xor(v, o);
    return v;
}
__device__ __forceinline__ float smax16(float v) {
#pragma unroll
    for (int o = 1; o < 16; o <<= 1) v = fmaxf(v, __shfl_xor(v, o));
    return v;
}
__device__ __forceinline__ void phase_sw_att(const int tid_l, const int bid_l, const bf16_t* Q, const bf16_t* Kb, const bf16_t* Vb, const float* sinks, bf16_t* O, LAS unsigned char* lds) {
    LAS bf16_t* Ks = (LAS bf16_t*)lds;
    LAS bf16_t* Vt = (LAS bf16_t*)(lds + 36864);
    LAS bf16_t* Qs = (LAS bf16_t*)(lds + 36864 + 35840);
    LAS bf16_t* Ps = (LAS bf16_t*)(lds + 36864 + 35840 + 18432);
    const int tid = tid_l, lane = tid & 63, w = __builtin_amdgcn_readfirstlane(tid >> 6), fr = lane & 15, fq = lane >> 4, dq = fq * 4 - fr;
    LAS bf16_t* Pw = Ps + w * 16 * 168;
    for (int item = bid_l; item < 512; item += gridDim.x) {
        const int b = item >> 6, n = (item >> 1) & 31, hk = item & 1;
        __syncthreads();
        for (int id = tid; id < 2048; id += NTHR) { const int key = id >> 3, dc = id & 7; const int pos = n * 128 - 128 + key;
            u32x4 kv = {0u, 0u, 0u, 0u};
            if (pos >= 0) kv = *(const u32x4*)(Kb + ((size_t)b * 4096 + pos) * 128 + hk * 64 + dc * 8);
            *(LAS u32x4*)(Ks + key * 72 + dc * 8) = kv; }
        for (int id = tid; id < 1024; id += NTHR) { const int kp = id >> 3, dc = id & 7; const int pos = n * 128 - 128 + 2 * kp;
            u32x4 v0 = {0u, 0u, 0u, 0u}, v1 = {0u, 0u, 0u, 0u};
            if (pos >= 0) { const size_t o = ((size_t)b * 4096 + pos) * 128 + hk * 64 + dc * 8; v0 = *(const u32x4*)(Vb + o); v1 = *(const u32x4*)(Vb + o + 128); }
            LAS unsigned* vp = (LAS unsigned*)(Vt + (dc * 8) * 280 + 2 * kp);
            vp[0 * 140] = (v0.x & 0xffffu) | (v1.x << 16); vp[1 * 140] = (v0.x >> 16) | (v1.x & 0xffff0000u);
            vp[2 * 140] = (v0.y & 0xffffu) | (v1.y << 16); vp[3 * 140] = (v0.y >> 16) | (v1.y & 0xffff0000u);
            vp[4 * 140] = (v0.z & 0xffffu) | (v1.z << 16); vp[5 * 140] = (v0.z >> 16) | (v1.z & 0xffff0000u);
            vp[6 * 140] = (v0.w & 0xffffu) | (v1.w << 16); vp[7 * 140] = (v0.w >> 16) | (v1.w & 0xffff0000u); }
        for (int id = tid; id < 64 * 8; id += NTHR) *(LAS unsigned*)(Vt + (id >> 3) * 280 + 256 + 2 * (id & 7)) = 0u;
        for (int g = 0; g < 8; ++g) {
            const int hq = hk * 8 + g;
            __syncthreads();
            for (int id = tid; id < 1024; id += NTHR) { const int qi = id >> 3, dc = id & 7;
                *(LAS u32x4*)(Qs + qi * 72 + dc * 8) = *(const u32x4*)(Q + ((size_t)b * 4096 + n * 128 + qi) * 1024 + hq * 64 + dc * 8); }
            __syncthreads();
            const float sink = sinks[hq];
            f32x4 sc[9];
#pragma unroll
            for (int t = 0; t < 9; ++t) { f32x4 a = {0.f, 0.f, 0.f, 0.f};
#pragma unroll
                for (int kc = 0; kc < 2; ++kc) a = mma16(Qs + (16 * w + fr) * 72 + kc * 32 + fq * 8, Ks + (16 * (w + t) + fr) * 72 + kc * 32 + fq * 8, a);
                sc[t] = a; }
            float mx[4] = {-INFINITY, -INFINITY, -INFINITY, -INFINITY};
#pragma unroll
            for (int t = 0; t < 9; ++t)
#pragma unroll
                for (int j = 0; j < 4; ++j) {
                    bool valid = true;
                    if (t == 0) valid = (dq + j) < 0;
                    if (t == 8) valid = (dq + j) >= 0;
                    if (n == 0 && (w + t) < 8) valid = false;
                    const float s = valid ? sc[t][j] * 0.125f : -INFINITY; sc[t][j] = s; mx[j] = fmaxf(mx[j], s); }
            float den[4];
#pragma unroll
            for (int j = 0; j < 4; ++j) { mx[j] = fmaxf(max16(mx[j]), sink); den[j] = 0.f; }
#pragma unroll
            for (int t = 0; t < 9; ++t)
#pragma unroll
                for (int j = 0; j < 4; ++j) { const float pz = __expf(sc[t][j] - mx[j]); sc[t][j] = pz; den[j] += pz; }
#pragma unroll
            for (int j = 0; j < 4; ++j) den[j] = 1.f / (sum16(den[j]) + __expf(sink - mx[j]));
#pragma unroll
            for (int t = 0; t < 9; ++t)
#pragma unroll
                for (int j = 0; j < 4; ++j) Pw[(fq * 4 + j) * 168 + 16 * t + fr] = f2bf(SWT >= 2 ? 0.0078125f + 0.f * den[j] : sc[t][j] * den[j]);
#pragma unroll
            for (int j = 0; j < 4; ++j) Pw[(fq * 4 + j) * 168 + 144 + fr] = 0;
            __syncthreads();
#pragma unroll
            for (int dt = 0; dt < 4; ++dt) { f32x4 a = {0.f, 0.f, 0.f, 0.f};
#pragma unroll
                for (int kc = 0; kc < 5; ++kc) a = mma16(Vt + (dt * 16 + fr) * 280 + 16 * w + kc * 32 + fq * 8, Pw + fr * 168 + kc * 32 + fq * 8, a);
                *(u32x2*)(O + ((size_t)b * 4096 + n * 128 + 16 * w + fr) * 1024 + hq * 64 + dt * 16 + fq * 4) = pk4(a); }
        }
    }
}

__device__ __forceinline__ void phase_sg_stats(const int tid_l, const int bid_l, const float* stp, float* stats) {
    const size_t gt = (size_t)bid_l * NTHR + tid_l, gn = (size_t)gridDim.x * NTHR;
    for (size_t row = gt; row < (size_t)MTOK; row += gn) { const f32x4* p = (const f32x4*)(stp + row * 64); float s1 = 0.f, s2 = 0.f;
#pragma unroll
        for (int q = 0; q < 16; ++q) { const f32x4 t = p[q]; s1 += t[0] + t[2]; s2 += t[1] + t[3]; }
        const float mu = s1 * (1.f / 2048.f), var = s2 * (1.f / 2048.f) - mu * mu;
        *(f32x2*)(stats + row * 2) = (f32x2){mu, rsqrtf(var + EPS)}; }
}
__device__ __forceinline__ void phase_sg_core(const int tid_l, const int bid_l, bf16_t* U, const bf16_t* V, const float* stats, const bf16_t* Wsm, const float* b_s, const float* ln_g, const float* ln_b, LAS unsigned char* lds) {
    LAS bf16_t* Ws = (LAS bf16_t*)lds;
    LAS bf16_t* Vt = (LAS bf16_t*)(lds + 34816);
    const int tid = tid_l, lane = tid & 63, w = tid >> 6, fr = lane & 15, fq = lane >> 4;
    int gprev = -1;
    for (int item = bid_l; item < 4096; item += gridDim.x) {
        const int g = item & 15, n = (item >> 4) & 31, b = item >> 9;
        const size_t t0 = (size_t)b * 4096 + n * 128;
        __syncthreads();
        if (g != gprev) { gprev = g;
            for (int id = tid; id < 2048; id += NTHR) { const int t = id >> 4, sc8 = id & 15;
                *(LAS u32x4*)(Ws + t * 136 + sc8 * 8) = *(const u32x4*)(Wsm + ((size_t)g * 128 + t) * 128 + sc8 * 8); } }
        for (int id = tid; id < 2048; id += NTHR) { const int cc = id >> 7, s = id & 127; const size_t tok = t0 + s;
            const float mu = stats[tok * 2], rstd = stats[tok * 2 + 1];
            const u32x4 raw = *(const u32x4*)(V + tok * 2048 + g * 128 + cc * 8);
            const float* lg = ln_g + g * 128 + cc * 8; const float* lb = ln_b + g * 128 + cc * 8;
            const unsigned rw[4] = {raw.x, raw.y, raw.z, raw.w};
#pragma unroll
            for (int q = 0; q < 4; ++q) { const float v0 = (bflo(rw[q]) - mu) * rstd * lg[2 * q] + lb[2 * q], v1 = (bfhi(rw[q]) - mu) * rstd * lg[2 * q + 1] + lb[2 * q + 1];
                Vt[(cc * 8 + 2 * q) * 136 + s] = f2bf(v0); Vt[(cc * 8 + 2 * q + 1) * 136 + s] = f2bf(v1); } }
        __syncthreads();
        const int kmax = (16 * w + 15) >> 5;
        const int trow = 16 * w + fr; const float bs = b_s[g * 128 + trow];
#pragma unroll
        for (int ct = 0; ct < 8; ++ct) { f32x4 a = {0.f, 0.f, 0.f, 0.f};
            for (int kc = 0; kc <= kmax; ++kc) a = mma16(Vt + (ct * 16 + fr) * 136 + kc * 32 + fq * 8, Ws + (16 * w + fr) * 136 + kc * 32 + fq * 8, a);
            bf16_t* up = U + (t0 + trow) * 2048 + g * 128 + ct * 16 + fq * 4;
            *(u32x2*)up = pk4(unpk4(*(const u32x2*)up) * (a + bs)); }
    }
}

constexpr int GLD = 3328;
constexpr int BCS = 129;
__device__ __forceinline__ void gla_bcum(const int tid_l, const bf16_t* proj, size_t t0, int h, const float* w_a2, const float* b_a, LAS float* bc, LAS float* al, LAS float* gtot) {
    const int tid = tid_l, k = tid & 127, ig = tid >> 7;
    for (int id = tid; id < 1024; id += NTHR) al[id] = bf2f(proj[(t0 + (id >> 4)) * GLD + 3072 + (id & 15)]);
    float wj[16];
#pragma unroll
    for (int j = 0; j < 16; ++j) wj[j] = w_a2[(size_t)j * 512 + h * 128 + k];
    const float ba = b_a[h * 128 + k];
    __syncthreads();
    float run = 0.f;
#pragma unroll 4
    for (int ii = 0; ii < 16; ++ii) { const int i = ig * 16 + ii; const LAS f32x4* ap = (const LAS f32x4*)(al + i * 16); const f32x4 a0 = ap[0], a1 = ap[1], a2 = ap[2], a3 = ap[3];
        float z = ba;
        z += a0[0] * wj[0] + a0[1] * wj[1] + a0[2] * wj[2] + a0[3] * wj[3]; z += a1[0] * wj[4] + a1[1] * wj[5] + a1[2] * wj[6] + a1[3] * wj[7];
        z += a2[0] * wj[8] + a2[1] * wj[9] + a2[2] * wj[10] + a2[3] * wj[11]; z += a3[0] * wj[12] + a3[1] * wj[13] + a3[2] * wj[14] + a3[3] * wj[15];
        run += -softplusf_(-z) * (1.f / 16.f); bc[i * BCS + k] = run; }
    gtot[ig * 128 + k] = run;
    __syncthreads();
    float off = 0.f;
    for (int g = 0; g < ig; ++g) off += gtot[g * 128 + k];
    if (ig > 0) {
#pragma unroll 4
        for (int ii = 0; ii < 16; ++ii) bc[(ig * 16 + ii) * BCS + k] += off; }
    __syncthreads();
}
__device__ __forceinline__ void phase_gla1(const int tid_l, const int bid_l, const bf16_t* proj, const float* w_a2, const float* b_a, bf16_t* dS, float* gdc, LAS unsigned char* lds) {
    LAS float* bc = (LAS float*)lds;
    LAS float* al = (LAS float*)(lds + 33280);
    LAS float* wa2 = (LAS float*)(lds + 37376);
    LAS bf16_t* KsT = (LAS bf16_t*)(lds + 45056);
    LAS bf16_t* Vt = (LAS bf16_t*)(lds + 45056 + 18432);
    const int tid = tid_l, lane = tid & 63, w = tid >> 6, fr = lane & 15, fq = lane >> 4;
    for (int item = bid_l; item < 2048; item += gridDim.x) {
        const int h = item & 3, bn = item >> 2; const size_t t0 = (size_t)bn * 64;
        __syncthreads();
        gla_bcum(tid_l, proj, t0, h, w_a2, b_a, bc, al, wa2);
        for (int id = tid; id < 1024; id += NTHR) { const int kc8 = id >> 6, j = id & 63; const u32x4 raw = *(const u32x4*)(proj + (t0 + j) * GLD + 512 + h * 128 + kc8 * 8); const unsigned rw[4] = {raw.x, raw.y, raw.z, raw.w};
#pragma unroll
            for (int q = 0; q < 4; ++q) { const int k0 = kc8 * 8 + 2 * q;
                KsT[k0 * 72 + j] = f2bf(bflo(rw[q]) * __expf(bc[63 * BCS + k0] - bc[j * BCS + k0]));
                KsT[(k0 + 1) * 72 + j] = f2bf(bfhi(rw[q]) * __expf(bc[63 * BCS + k0 + 1] - bc[j * BCS + k0 + 1])); } }
        for (int id = tid; id < 2048; id += NTHR) { const int vc8 = id >> 6, j = id & 63; const u32x4 raw = *(const u32x4*)(proj + (t0 + j) * GLD + 1024 + h * 256 + vc8 * 8); const unsigned rw[4] = {raw.x, raw.y, raw.z, raw.w};
#pragma unroll
            for (int q = 0; q < 4; ++q) { Vt[(vc8 * 8 + 2 * q) * 72 + j] = (bf16_t)(rw[q] & 0xffff); Vt[(vc8 * 8 + 2 * q + 1) * 72 + j] = (bf16_t)(rw[q] >> 16); } }
        if (tid < 128) gdc[(size_t)item * 128 + tid] = __expf(bc[63 * BCS + tid]);
        __syncthreads();
#pragma unroll
        for (int vi = 0; vi < 2; ++vi) { const int vt = 2 * w + vi;
#pragma unroll
            for (int kt = 0; kt < 8; ++kt) { f32x4 a = {0.f, 0.f, 0.f, 0.f};
#pragma unroll
                for (int kc = 0; kc < 2; ++kc) a = mma16(KsT + (kt * 16 + fr) * 72 + kc * 32 + fq * 8, Vt + (vt * 16 + fr) * 72 + kc * 32 + fq * 8, a);
                *(u32x2*)(dS + (size_t)item * 32768 + (size_t)(vt * 16 + fr) * 128 + kt * 16 + fq * 4) = pk4(a); } }
    }
}
__device__ __forceinline__ void phase_gla2(const int tid_l, const int bid_l, bf16_t* dS, const float* gdc) {
    const size_t gt = (size_t)bid_l * NTHR + tid_l, gn = (size_t)gridDim.x * NTHR;
    for (size_t i = gt; i < (size_t)32 * 4096; i += gn) {
        const int bh = (int)(i >> 12), e0 = (int)(i & 4095) * 8, b = bh >> 2, h = bh & 3, k0 = e0 & 127;
        float s[8];
#pragma unroll
        for (int q = 0; q < 8; ++q) s[q] = 0.f;
#pragma unroll 8
        for (int n = 0; n < 64; ++n) { const size_t item = ((size_t)b * 64 + n) * 4 + h; bf16_t* ptr = dS + item * 32768 + e0;
            const u32x4 raw = *(const u32x4*)ptr; const f32x4 d0 = *(const f32x4*)(gdc + item * 128 + k0), d1 = *(const f32x4*)(gdc + item * 128 + k0 + 4);
            u32x4 o; o.x = pk2(s[0], s[1]); o.y = pk2(s[2], s[3]); o.z = pk2(s[4], s[5]); o.w = pk2(s[6], s[7]); *(u32x4*)ptr = o;
            s[0] = s[0] * d0[0] + bflo(raw.x); s[1] = s[1] * d0[1] + bfhi(raw.x); s[2] = s[2] * d0[2] + bflo(raw.y); s[3] = s[3] * d0[3] + bfhi(raw.y);
            s[4] = s[4] * d1[0] + bflo(raw.z); s[5] = s[5] * d1[1] + bfhi(raw.z); s[6] = s[6] * d1[2] + bflo(raw.w); s[7] = s[7] * d1[3] + bfhi(raw.w); }
    }
}
__device__ __forceinline__ void phase_gla3(const int tid_l, const int bid_l, bf16_t* proj, const float* w_a2, const float* b_a, const bf16_t* dS, const float* gn_g, LAS unsigned char* lds) {
    LAS float* bc = (LAS float*)lds;
    LAS float* al = (LAS float*)(lds + 33280);
    LAS float* wa2 = (LAS float*)(lds + 37376);
    LAS bf16_t* Qg = (LAS bf16_t*)(lds + 45056);
    LAS bf16_t* Kg = (LAS bf16_t*)(lds + 62464);
    LAS bf16_t* At = (LAS bf16_t*)(lds + 79872);
    LAS bf16_t* Vt = (LAS bf16_t*)(lds + 89088);
    LAS bf16_t* St = (LAS bf16_t*)(lds + 107520);
    LAS float* ssq = (LAS float*)(lds + 142336);
    const int tid = tid_l, lane = tid & 63, w = tid >> 6, fr = lane & 15, fq = lane >> 4;
    for (int item = bid_l; item < 2048; item += gridDim.x) {
        const int h = item & 3, bn = item >> 2; const size_t t0 = (size_t)bn * 64;
        __syncthreads();
        gla_bcum(tid_l, proj, t0, h, w_a2, b_a, bc, al, wa2);
        for (int id = tid; id < 1024; id += NTHR) { const int i = id >> 4, kc8 = id & 15;
            const u32x4 rq = *(const u32x4*)(proj + (t0 + i) * GLD + h * 128 + kc8 * 8), rk = *(const u32x4*)(proj + (t0 + i) * GLD + 512 + h * 128 + kc8 * 8);
            const unsigned q4[4] = {rq.x, rq.y, rq.z, rq.w}, k4[4] = {rk.x, rk.y, rk.z, rk.w}; unsigned oq[4], ok[4];
#pragma unroll
            for (int q = 0; q < 4; ++q) { const float b0 = bc[i * BCS + kc8 * 8 + 2 * q], b1 = bc[i * BCS + kc8 * 8 + 2 * q + 1]; const float e0 = __expf(b0), e1 = __expf(b1);
                oq[q] = pk2(bflo(q4[q]) * 0.08838834764831845f * e0, bfhi(q4[q]) * 0.08838834764831845f * e1);
                ok[q] = pk2(bflo(k4[q]) / e0, bfhi(k4[q]) / e1); }
            *(LAS u32x4*)(Qg + i * 136 + kc8 * 8) = (u32x4){oq[0], oq[1], oq[2], oq[3]}; *(LAS u32x4*)(Kg + i * 136 + kc8 * 8) = (u32x4){ok[0], ok[1], ok[2], ok[3]}; }
        __syncthreads();
        { const int it = w >> 1;
#pragma unroll
          for (int x = 0; x < 2; ++x) { const int jt = (w & 1) * 2 + x; f32x4 a = {0.f, 0.f, 0.f, 0.f};
#pragma unroll
              for (int kc = 0; kc < 4; ++kc) a = mma16(Qg + (it * 16 + fr) * 136 + kc * 32 + fq * 8, Kg + (jt * 16 + fr) * 136 + kc * 32 + fq * 8, a);
#pragma unroll
              for (int j = 0; j < 4; ++j) { const int i = it * 16 + fq * 4 + j, jj = jt * 16 + fr; At[i * 72 + jj] = f2bf(jj <= i ? a[j] : 0.f); } } }
        const int rb = w & 3, cq = w >> 2;
        f32x4 oacc[8];
#pragma unroll
        for (int x = 0; x < 8; ++x) oacc[x] = (f32x4){0.f, 0.f, 0.f, 0.f};
#pragma unroll
        for (int half = 0; half < 2; ++half) {
            __syncthreads();
            for (int id = tid; id < 1024; id += NTHR) { const int vc8 = id >> 6, j = id & 63; const u32x4 raw = *(const u32x4*)(proj + (t0 + j) * GLD + 1024 + h * 256 + half * 128 + vc8 * 8); const unsigned rw[4] = {raw.x, raw.y, raw.z, raw.w};
#pragma unroll
                for (int q = 0; q < 4; ++q) { Vt[(vc8 * 8 + 2 * q) * 72 + j] = (bf16_t)(rw[q] & 0xffff); Vt[(vc8 * 8 + 2 * q + 1) * 72 + j] = (bf16_t)(rw[q] >> 16); } }
            for (int id = tid; id < 2048; id += NTHR) { const int v = id >> 4, kc8 = id & 15;
                *(LAS u32x4*)(St + v * 136 + kc8 * 8) = *(const u32x4*)(dS + (size_t)item * 32768 + (size_t)(half * 128 + v) * 128 + kc8 * 8); }
            __syncthreads();
#pragma unroll
            for (int x = 0; x < 4; ++x) { const int vt = cq * 4 + x; f32x4 a = oacc[half * 4 + x];
#pragma unroll
                for (int kc = 0; kc < 2; ++kc) a = mma16(Vt + (vt * 16 + fr) * 72 + kc * 32 + fq * 8, At + (rb * 16 + fr) * 72 + kc * 32 + fq * 8, a);
#pragma unroll
                for (int kc = 0; kc < 4; ++kc) a = mma16(St + (vt * 16 + fr) * 136 + kc * 32 + fq * 8, Qg + (rb * 16 + fr) * 136 + kc * 32 + fq * 8, a);
                oacc[half * 4 + x] = a; }
        }
        { float sacc = 0.f;
#pragma unroll
          for (int x = 0; x < 8; ++x) sacc += (oacc[x][0] * oacc[x][0] + oacc[x][1] * oacc[x][1]) + (oacc[x][2] * oacc[x][2] + oacc[x][3] * oacc[x][3]);
          sacc = xrow_sum(sacc);
          if (fq == 0) ssq[(rb * 16 + fr) * 2 + cq] = sacc; }
        __syncthreads();
        { const int i = rb * 16 + fr; const float rstd = rsqrtf((ssq[i * 2] + ssq[i * 2 + 1]) * (1.f / 256.f) + EPS);
#pragma unroll
          for (int x = 0; x < 8; ++x) { const int v0 = (x >> 2) * 128 + (cq * 4 + (x & 3)) * 16 + fq * 4; bf16_t* gp = proj + (t0 + i) * GLD + 2048 + h * 256 + v0;
              const f32x4 gate = unpk4(*(const u32x2*)gp), gg = *(const f32x4*)(gn_g + h * 256 + v0); f32x4 z;
#pragma unroll
              for (int j = 0; j < 4; ++j) z[j] = oacc[x][j] * rstd * gg[j] * (gate[j] * __builtin_amdgcn_rcpf(1.f + __expf(-gate[j])));
              *(u32x2*)gp = pk4(z); } }
    }
}


#define XB_TMO      128
#define XB_XCNT(j)  (256  + 64 * (j))
#define XB_XSUB(j)  (1280 + 64 * (j))
#define XB_XGEN(j)  (2304 + 64 * (j))
#define XB_TOP      3328
#define XB_TOPGEN   3392
#define XCD_BAR_WORDS 3456
#define XB_SPIN_CAP (1u << 18)
__device__ __forceinline__ unsigned xb_ld(unsigned* p)              { return __hip_atomic_load(p, __ATOMIC_RELAXED, __HIP_MEMORY_SCOPE_AGENT); }
__device__ __forceinline__ unsigned xb_add(unsigned* p, unsigned v) { return __hip_atomic_fetch_add(p, v, __ATOMIC_RELAXED, __HIP_MEMORY_SCOPE_AGENT); }
__device__ __forceinline__ unsigned xb_xcc_id() { return (unsigned)__builtin_amdgcn_s_getreg((3 << 11) | 20) & 0xFu; }
#define XB_SPIN(cond, bar) do { unsigned _sp = 0; while (cond) { __builtin_amdgcn_s_sleep(1); \
    if ((++_sp & 255u) == 0u) { if (xb_ld(&(bar)[XB_TMO])) break; if (_sp > XB_SPIN_CAP) { atomicAdd(&(bar)[XB_TMO], 1u); break; } } } } while (0)
struct XcdBarrier { unsigned* bar; unsigned x; volatile LAS unsigned* st; };
__device__ __forceinline__ void xcd_barrier_complete(unsigned* bar, unsigned x, unsigned& nloc, unsigned& nx) {
    const unsigned G = gridDim.x * gridDim.y * gridDim.z;
    unsigned sum, cnt, mine, sp = 0u;
    for (;;) {
        sum = 0u; cnt = 0u; mine = 0u;
#pragma unroll
        for (unsigned j = 0; j < 16; ++j) { const unsigned c = xb_ld(&bar[XB_XCNT(j)]); sum += c; cnt += (c > 0u) ? 1u : 0u; mine = (j == x) ? c : mine; }
        if (sum == G) break;
        __builtin_amdgcn_s_sleep(1);
        if ((++sp & 255u) == 0u) { if (xb_ld(&bar[XB_TMO])) break; if (sp > XB_SPIN_CAP) { atomicAdd(&bar[XB_TMO], 1u); break; } }
    }
    nloc = mine > 0u ? mine : 1u; nx = cnt > 0u ? cnt : 1u;
}
__device__ __forceinline__ void xcd_barrier(const XcdBarrier& b) {
    asm volatile("s_waitcnt vmcnt(0)" ::: "memory");
    __syncthreads();
    if (threadIdx.x == 0) {
        unsigned* bar = b.bar;
        __builtin_amdgcn_s_waitcnt(0);
        unsigned nloc = b.st[0], nx = b.st[1];
        if (nloc == 0u) { xcd_barrier_complete(bar, b.x, nloc, nx); b.st[0] = nloc; b.st[1] = nx; }
        const unsigned old = xb_add(&bar[XB_XSUB(b.x)], 1u);
        const unsigned gen = old / nloc;
        if (old + 1u == (gen + 1u) * nloc) {
            __builtin_amdgcn_fence(__ATOMIC_RELEASE, "agent");
            asm volatile("s_waitcnt vmcnt(0)" ::: "memory");
            const unsigned og = xb_add(&bar[XB_TOP], 1u);
            const unsigned tg = og / nx;
            if (og + 1u == (tg + 1u) * nx) xb_add(&bar[XB_TOPGEN], 1u);
            else XB_SPIN(xb_ld(&bar[XB_TOPGEN]) == tg, bar);
            __builtin_amdgcn_fence(__ATOMIC_ACQUIRE, "agent");
            xb_add(&bar[XB_XGEN(b.x)], 1u);
            asm volatile("s_waitcnt vmcnt(0)" ::: "memory");
        } else {
            XB_SPIN(xb_ld(&bar[XB_XGEN(b.x)]) == gen, bar);
            __builtin_amdgcn_fence(__ATOMIC_ACQUIRE, "agent");
            asm volatile("s_waitcnt vmcnt(0)" ::: "memory");
        }
    }
    __syncthreads();
}
constexpr int XBST_OFF = 147296;

#define LAUNDER() asm volatile("" : "+v"(tid_l), "+s"(bid_l) :: "memory")
constexpr int NPHASE = 34;
#ifndef PHMASK
#define PHMASK 0xFFFFFFFFFFFFFFFFull
#endif
#define ON(n) ((((unsigned long long)(PHMASK)) >> (n)) & 1ull)
template <int PH> __device__ __forceinline__ void do_phase(const LAS unsigned long long* ptab, LAS unsigned char* lds) {
    constexpr int ph = PH;

        int tid_l = threadIdx.x, bid_l = blockIdx.x; LAUNDER();
        float* const H = (float*)inp(ptab, 41);
        unsigned char* const ws = (unsigned char*)inp(ptab, 42);
        bf16_t* const A0 = (bf16_t*)SLOTP(0); bf16_t* const A1 = (bf16_t*)SLOTP(1); bf16_t* const A2 = (bf16_t*)SLOTP(2); bf16_t* const A3 = (bf16_t*)SLOTP(3); bf16_t* const A4 = (bf16_t*)SLOTP(4); bf16_t* const A5 = (bf16_t*)SLOTP(5);
        int fl = -1, fp = 0;
        if (ph >= 7 && ph <= 9) { fl = 0; fp = ph - 7; } else if (ph >= 14 && ph <= 16) { fl = 1; fp = ph - 14; } else if (ph >= 21 && ph <= 23) { fl = 2; fp = ph - 21; } else if (ph >= 30 && ph <= 32) { fl = 3; fp = ph - 30; }
        if (fl >= 0) {
            if (fp == 0) { if (ON(7)) phase_norm(tid_l, bid_l, H, inp(ptab, 3) + fl * 1024, A0); }
            else if (fp == 1) { if (ON(8)) pg8::gemm_phase(tid_l, bid_l, lds, Gemm{A0, (const bf16_t*)(ws + W_FFN_IN) + (size_t)fl * 5632 * 1024, MTOK, 5632, 1024, 1024, 0, 0}, EpiSwiglu{A1}); }
            else { if (ON(9)) pg8::gemm_phase(tid_l, bid_l, lds, Gemm{A1, (const bf16_t*)(ws + W_FFN_OUT) + (size_t)fl * 1024 * 2816, MTOK, 1024, 2816, 2816, 0, 0}, EpiResid{H, H, nullptr}); }
            return;
        }
        switch (ph) {
        case 0: if (ON(0)) { phase_prep(tid_l, bid_l, ptab, ws, lds); } break;
        case 1: if (ON(1)) { phase_rw_norm(tid_l, bid_l, inp(ptab, 0), inp(ptab, 2), inp(ptab, 7), A0, (bf16_t*)H, (bf16_t*)H + (size_t)MTOK * 1024, A1); } break;
        case 2: if (ON(2)) {
            const bf16_t* wr = (const bf16_t*)(ws + W_RKV);
            pg8::gemm_phase(tid_l, bid_l, lds, Gemm{(const bf16_t*)H, wr, MTOK, 1024, 1024, 1024, 0, 0}, EpiBf16{A2, 1024}); LAUNDER();
            pg8::gemm_phase(tid_l, bid_l, lds, Gemm{(const bf16_t*)H + (size_t)MTOK * 1024, wr + (size_t)1024 * 1024, MTOK, 1024, 1024, 1024, 0, 0}, EpiBf16{A3, 1024}); LAUNDER();
            pg8::gemm_phase(tid_l, bid_l, lds, Gemm{A1, wr + (size_t)2 * 1024 * 1024, MTOK, 1024, 1024, 1024, 0, 1}, EpiBf16{A4, 1024}); LAUNDER();
            pg8::gemm_phase(tid_l, bid_l, lds, Gemm{A0, (const bf16_t*)(ws + W_L1), MTOK, 256, 2048, 1024, 1, 0}, EpiLora1{A5});
        } break;
        case 3: if (ON(3)) { pg8::gemm_phase(tid_l, bid_l, lds, Gemm{A5, (const bf16_t*)(ws + W_L2), MTOK, 3072, 256, 256, 0, 0}, EpiLora2{H, A0, A1, inp(ptab, 9), inp(ptab, 12)}); } break;
        case 4: if (ON(4)) { phase_rw_scan(tid_l, bid_l, A2, A3, A4, A0, H, inp(ptab, 17), inp(ptab, 18), A5, lds, ptab, ws); } break;
        case 5: if (ON(5)) { phase_rw_post(tid_l, bid_l, A5, A2, A3, A4, A0, A1, inp(ptab, 18), inp(ptab, 19), inp(ptab, 20), inp(ptab, 21), A5); } break;
        case 6: if (ON(6)) { pg8::gemm_phase(tid_l, bid_l, lds, Gemm{A5, (const bf16_t*)(ws + W_RWO), MTOK, 1024, 1024, 1024, 0, 0}, EpiResid{inp(ptab, 0), H, nullptr}); } break;
        case 10: if (ON(10)) { phase_norm(tid_l, bid_l, H, inp(ptab, 2) + 1024, A0); } break;
        case 11: if (ON(11)) { pg8::gemm_phase(tid_l, bid_l, lds, Gemm{A0, (const bf16_t*)(ws + W_QKV), MTOK, 1280, 1024, 1024, 0},
                                 EpiQKV{A1, A2, A2 + (size_t)16 * 1024 * 1024, inp(ptab, 24), (const float*)(ws + T_COS), (const float*)(ws + T_SIN)}); } break;
        case 12: if (ON(12)) {
#ifdef SW_COPY
            { const size_t gt = (size_t)bid_l * NTHR + tid_l, gn = (size_t)gridDim.x * NTHR; const u32x4* src = (const u32x4*)A1; u32x4* dst = (u32x4*)A3; for (size_t i = gt; i < (size_t)MTOK * 1024 / 8; i += gn) { const size_t row = i >> 7; const int c8 = (int)(i & 127); const u32x4 kq = *(const u32x4*)(A2 + row * 128 + (c8 & 15) * 8), vq = *(const u32x4*)(A2 + (size_t)16 * 1024 * 1024 + row * 128 + (c8 & 15) * 8); u32x4 o = src[i]; o.x ^= kq.x + vq.y; o.y = kq.y; o.z = vq.z; o.w ^= kq.w ^ vq.x; dst[i] = o; } }
#else
            phase_sw_att(tid_l, bid_l, A1, A2, A2 + (size_t)16 * 1024 * 1024, inp(ptab, 25), A3, lds);
#endif
            } break;
        case 13: if (ON(13)) { pg8::gemm_phase(tid_l, bid_l, lds, Gemm{A3, (const bf16_t*)(ws + W_SWO), MTOK, 1024, 1024, 1024, 0, 0}, EpiResid{H, H, inp(ptab, 27)}); } break;
        case 17: if (ON(17)) { phase_norm(tid_l, bid_l, H, inp(ptab, 2) + 2048, A0); } break;
        case 18: if (ON(18)) { pg8::gemm_phase(tid_l, bid_l, lds, Gemm{A0, (const bf16_t*)(ws + W_SGIN), MTOK, 4096, 1024, 1024, 0, 0}, EpiSGUin{A1, A3, inp(ptab, 29), (float*)(ws + T_STP)}); } break;
        case 19: if (ON(19)) {
            phase_sg_stats(tid_l, bid_l, (const float*)(ws + T_STP), (float*)(ws + T_STATS));
            { XcdBarrier xb; xb.bar = (unsigned*)(ws + T_BAR); xb.x = xb_xcc_id(); xb.st = (volatile LAS unsigned*)(lds + XBST_OFF); xcd_barrier(xb); }
            phase_sg_core(tid_l, bid_l, A1, A3, (const float*)(ws + T_STATS), (const bf16_t*)(ws + W_SGS), inp(ptab, 33), inp(ptab, 30), inp(ptab, 31), lds); } break;
        case 20: if (ON(20)) { pg8::gemm_phase(tid_l, bid_l, lds, Gemm{A1, (const bf16_t*)(ws + W_SGO), MTOK, 1024, 2048, 2048, 0, 0}, EpiResid{H, H, inp(ptab, 35)}); } break;
        case 24: if (ON(24)) { phase_norm(tid_l, bid_l, H, inp(ptab, 2) + 3072, A5); } break;
        case 25: if (ON(25)) { pg8::gemm_phase(tid_l, bid_l, lds, Gemm{A5, (const bf16_t*)(ws + W_GLIN), MTOK, 3328, 1024, 1024, 0, 0}, EpiBf16{A0, GLD}); } break;
        case 26: if (ON(26)) { phase_gla1(tid_l, bid_l, A0, inp(ptab, 37), inp(ptab, 38), A4, (float*)(ws + T_GDC), lds); } break;
        case 27: if (ON(27) && GT != 3) { phase_gla2(tid_l, bid_l, A4, (const float*)(ws + T_GDC)); } break;
        case 28: if (ON(28) && GT != 1) { phase_gla3(tid_l, bid_l, A0, inp(ptab, 37), inp(ptab, 38), A4, inp(ptab, 39), lds); } break;
        case 29: if (ON(29)) { pg8::gemm_phase(tid_l, bid_l, lds, Gemm{A0 + 2048, (const bf16_t*)(ws + W_GLO), MTOK, 1024, 1024, GLD, 0, 0}, EpiResid{H, H, nullptr}); } break;
        case 33: if (ON(33)) { phase_final(tid_l, bid_l, H, inp(ptab, 6)); } break;
        default: break;
        }
}
template <int PH, int HI> __device__ __forceinline__ void run_phases(cg::grid_group& grid, const LAS unsigned long long* ptab, LAS unsigned char* lds, bool first, unsigned nbar = 0) {
    if constexpr (PH < HI) {
        if (PH == 2) {
            asm volatile("s_waitcnt vmcnt(0) lgkmcnt(0)" ::: "memory");
            grid.sync();
        } else if (!first && PH != 1) {
            XcdBarrier xb; xb.bar = (unsigned*)((unsigned char*)inp(ptab, 42) + T_BAR); xb.x = xb_xcc_id(); xb.st = (volatile LAS unsigned*)(lds + XBST_OFF);
            xcd_barrier(xb);
        }
        do_phase<PH>(ptab, lds);
#ifdef REP_PH
        if (((REP_PH) >> PH) & 1ull) { __syncthreads(); do_phase<PH>(ptab, lds); }
#endif
        run_phases<PH + 1, HI>(grid, ptab, lds, false, nbar + 1);
    }
}
template <int LO, int HI> __global__ void __launch_bounds__(512, 2) mega(Params p) {
    extern __shared__ __attribute__((aligned(16))) unsigned char smem[];
    LAS unsigned char* lds = (LAS unsigned char*)smem;
    cg::grid_group grid = cg::this_grid();
    LAS unsigned long long* ptab = (LAS unsigned long long*)(lds + PTAB_OFF);
    { const int t = threadIdx.x;
#pragma unroll
      for (int i = 0; i < 41; ++i) { if (t == i) ptab[i] = (unsigned long long)p.in[i]; if ((i & 3) == 3) asm volatile("" ::: "memory"); }
      if (t == 41) ptab[41] = (unsigned long long)p.out;
      if (t == 42) ptab[42] = (unsigned long long)p.ws; }
    if (threadIdx.x == 0) { *(LAS unsigned*)(lds + XBST_OFF) = 0u; *(LAS unsigned*)(lds + XBST_OFF + 4) = 0u; }
    __syncthreads();
    if (threadIdx.x == 0) (void)xb_add(&((unsigned*)(p.ws + T_BAR))[XB_XCNT(xb_xcc_id())], 1u);
#ifdef TRUNC_AT
    run_phases<LO, TRUNC_AT>(grid, ptab, lds, true);
    run_phases<33, 34>(grid, ptab, lds, false, TRUNC_AT);
#else
    run_phases<LO, HI>(grid, ptab, lds, true);
#endif
}

extern "C" void kernel_launch(void* const* d_in, const int* in_sizes, int n_in, void* d_out, int out_size, void* d_ws, size_t ws_size, hipStream_t stream) {
    static int grid = 0;
    if (grid == 0) {
        if (n_in != 41 || ws_size < WS_END) { fprintf(stderr, "kernel_launch: unexpected inputs (n_in %d, ws %zu, need %zu)\n", n_in, ws_size, (size_t)WS_END); grid = -1; return; }
        int dev = 0, cus = 0, per_cu = 0;
        hipGetDevice(&dev); hipDeviceGetAttribute(&cus, hipDeviceAttributeMultiprocessorCount, dev);
        if (hipFuncSetAttribute((const void*)mega<0, NPHASE>, hipFuncAttributeMaxDynamicSharedMemorySize, LDS_BYTES) != hipSuccess) { fprintf(stderr, "kernel_launch: hipFuncSetAttribute failed\n"); grid = -1; return; }
        if (hipOccupancyMaxActiveBlocksPerMultiprocessor(&per_cu, (const void*)mega<0, NPHASE>, NTHR, LDS_BYTES) != hipSuccess || per_cu < 1) { fprintf(stderr, "kernel_launch: occupancy query says %d\n", per_cu); per_cu = 1; }
        (void)hipGetLastError();
        grid = cus;
    }
    if (grid < 0) return;
    (void)hipMemsetAsync((unsigned char*)d_ws + T_BAR, 0, XCD_BAR_WORDS * 4, stream);
    Params p{};
    for (int i = 0; i < 41; ++i) p.in[i] = (const float*)d_in[i];
    p.out = (float*)d_out; p.ws = (unsigned char*)d_ws; p.ph_lo = 0; p.ph_hi = NPHASE;
    void* args[] = {&p};
    hipError_t e = hipLaunchCooperativeKernel((const void*)mega<0, NPHASE>, dim3(grid), dim3(NTHR), args, LDS_BYTES, stream);
    if (e != hipSuccess) fprintf(stderr, "cooperative launch failed: %s (grid %d)\n", hipGetErrorString(e), grid);
}
```

```cpp
#define OWN_BARRIER 0
#define SWT 0
#define GT 0
#include <hip/hip_runtime.h>
#include <hip/hip_cooperative_groups.h>
#include <cstdio>
namespace cg = cooperative_groups;

#define LAS __attribute__((address_space(3)))
typedef unsigned short bf16_t;
typedef short bf16x8 __attribute__((ext_vector_type(8)));
typedef float f32x4 __attribute__((ext_vector_type(4)));
typedef float f32x2 __attribute__((ext_vector_type(2)));
typedef unsigned u32x4 __attribute__((ext_vector_type(4)));
typedef unsigned u32x2 __attribute__((ext_vector_type(2)));

constexpr int MTOK = 32768, DM = 1024, SEQ = 4096, NB = 8, FFH = 2816;
constexpr float EPS = 1e-5f;
constexpr int NTHR = 512;
constexpr int LDS_BYTES = 147456;

constexpr size_t W_FFN_IN = 0;
constexpr size_t W_FFN_OUT = W_FFN_IN + (size_t)4 * 5632 * 1024 * 2;
constexpr size_t W_RKV = W_FFN_OUT + (size_t)4 * 1024 * 2816 * 2;
constexpr size_t W_L1 = W_RKV + (size_t)3 * 1024 * 1024 * 2;
constexpr size_t W_L2 = W_L1 + (size_t)256 * 2048 * 2;
constexpr size_t W_RWO = W_L2 + (size_t)3072 * 256 * 2;
constexpr size_t W_QKV = W_RWO + (size_t)1024 * 1024 * 2;
constexpr size_t W_SWO = W_QKV + (size_t)1280 * 1024 * 2;
constexpr size_t W_SGIN = W_SWO + (size_t)1024 * 1024 * 2;
constexpr size_t W_SGO = W_SGIN + (size_t)4096 * 1024 * 2;
constexpr size_t W_SGS = W_SGO + (size_t)1024 * 2048 * 2;
constexpr size_t W_GLIN = W_SGS + (size_t)16 * 128 * 128 * 2;
constexpr size_t W_GLO = W_GLIN + (size_t)3328 * 1024 * 2;
constexpr size_t SLOT0 = W_GLO + (size_t)1024 * 1024 * 2;
constexpr size_t SLOT = (size_t)64 * 1024 * 1024 + 65536;
constexpr size_t TAIL = SLOT0 + 6 * SLOT;
constexpr size_t T_COS = TAIL;
constexpr size_t T_SIN = T_COS + (size_t)MTOK * 32 * 4;
constexpr size_t T_STATS = T_SIN + (size_t)MTOK * 32 * 4;
constexpr size_t T_GDC = T_STATS + (size_t)MTOK * 2 * 4;
constexpr size_t T_BAR = T_GDC + (size_t)2048 * 128 * 4;
constexpr size_t T_STP = T_BAR + 16384;
constexpr size_t WS_END = T_STP + (size_t)MTOK * 64 * 4;
static_assert(WS_END <= (size_t)536870912, "workspace overflow");
#define SLOTP(i) (ws + SLOT0 + (size_t)(i) * SLOT)

struct Params { const float* in[41]; float* out; unsigned char* ws; int ph_lo, ph_hi; };

typedef __bf16 bf16x2_t __attribute__((ext_vector_type(2)));
__device__ __forceinline__ unsigned pk2(float lo, float hi) { const f32x2 v = {lo, hi}; const bf16x2_t b = __builtin_convertvector(v, bf16x2_t); return __builtin_bit_cast(unsigned, b); }
__device__ __forceinline__ float bflo(unsigned w) { return __uint_as_float(w << 16); }
__device__ __forceinline__ float bfhi(unsigned w) { return __uint_as_float(w & 0xffff0000u); }
__device__ __forceinline__ float bf2f(bf16_t b) { return __uint_as_float(((unsigned)b) << 16); }
__device__ __forceinline__ bf16_t f2bf(float f) { return (bf16_t)(pk2(f, 0.f) & 0xffffu); }
__device__ __forceinline__ u32x2 pk4(f32x4 v) { u32x2 w; w.x = pk2(v[0], v[1]); w.y = pk2(v[2], v[3]); return w; }
__device__ __forceinline__ f32x4 unpk4(u32x2 w) { return (f32x4){bflo(w.x), bfhi(w.x), bflo(w.y), bfhi(w.y)}; }
template <int CTRL> __device__ __forceinline__ float dppmov(float x) { return __builtin_bit_cast(float, __builtin_amdgcn_mov_dpp(__builtin_bit_cast(int, x), CTRL, 0xf, 0xf, true)); }
__device__ __forceinline__ float sum16(float x) { x += dppmov<0xB1>(x); x += dppmov<0x4E>(x); x += dppmov<0x141>(x); x += dppmov<0x128>(x); return x; }
__device__ __forceinline__ float max16(float x) { x = fmaxf(x, dppmov<0xB1>(x)); x = fmaxf(x, dppmov<0x4E>(x)); x = fmaxf(x, dppmov<0x141>(x)); x = fmaxf(x, dppmov<0x128>(x)); return x; }
__device__ __forceinline__ float dsum16(float x) { return sum16(x); }
__device__ __forceinline__ float xrow_sum(float x) {
    auto s = __builtin_amdgcn_permlane16_swap(__float_as_uint(x), __float_as_uint(x), false, false);
    x = __uint_as_float(s[0]) + __uint_as_float(s[1]);
    auto t = __builtin_amdgcn_permlane32_swap(__float_as_uint(x), __float_as_uint(x), false, false);
    return __uint_as_float(t[0]) + __uint_as_float(t[1]);
}
__device__ __forceinline__ float wave_sum(float v) { return xrow_sum(sum16(v)); }
__device__ __forceinline__ float sigmoidf_(float x) { return __builtin_amdgcn_rcpf(1.f + __expf(-x)); }
__device__ __forceinline__ float softplusf_(float x) { return fmaxf(x, 0.f) + __logf(1.f + __expf(-fabsf(x))); }
__device__ __forceinline__ f32x2 gelu_pk(f32x2 v) {
    const f32x2 av = __builtin_elementwise_abs(v), d = av * 0.2316418882f + 1.0f;
    f32x2 t; t.x = __builtin_amdgcn_rcpf(d.x); t.y = __builtin_amdgcn_rcpf(d.y);
    f32x2 q = t * 0.5307027145f + (-0.7265760135f); q = q * t + 0.7107068705f; q = q * t + (-0.142248368f); q = q * t + 0.127414796f; q = q * t;
    const f32x2 s = (v * v) * (-0.72134752044f);
    f32x2 e; e.x = __builtin_amdgcn_exp2f(s.x); e.y = __builtin_amdgcn_exp2f(s.y);
    const f32x2 m = v * (q * e), r = v - m;
    f32x2 o; o.x = v.x < 0.f ? m.x : r.x; o.y = v.y < 0.f ? m.y : r.y; return o;
}
__device__ __forceinline__ f32x4 mma16(const LAS bf16_t* a, const LAS bf16_t* b, f32x4 c) {
    const bf16x8 av = *(const LAS bf16x8*)a; const bf16x8 bv = *(const LAS bf16x8*)b;
    return __builtin_amdgcn_mfma_f32_16x16x32_bf16(av, bv, c, 0, 0, 0);
}

constexpr int PTAB_OFF = 146944;
__device__ __forceinline__ const float* inp(const LAS unsigned long long* t, int i) {
    const unsigned long long v = t[i]; const unsigned lo = __builtin_amdgcn_readfirstlane((unsigned)v), hi = __builtin_amdgcn_readfirstlane((unsigned)(v >> 32));
    return (const float*)(((unsigned long long)hi << 32) | lo);
}
namespace pg8 {
constexpr int BM = 256, BK = 64, HALF = 128, HTB = HALF * BK * 2, NXCD = 8, WGM = 8;
__device__ __forceinline__ int lds_byte(int r, int c) { const int st = (r >> 4) * 2 + (c >> 5), rr = r & 15, cc = c & 31, ob = rr * 64 + cc * 2; return st * 1024 + (ob ^ (((ob >> 9) & 1) << 5)); }
__device__ __forceinline__ void stage_rc(int b, int& R, int& C) { const int st = b / 1024, sb = b % 1024, swz = sb ^ (((sb >> 9) & 1) << 5); R = (st >> 1) * 16 + swz / 64; C = (st & 1) * 32 + (swz % 64) / 2; }
struct Unit { int pm, pn; };
struct Gemm { const bf16_t* A; const bf16_t* Bt; int M, N, K, lda, gap, mode; };
struct StaticOrder {
    int nM, nN, nwg, G, c, mode;
    __device__ void init(int M, int N, int G_, int c_, int mode_) { nM = M / BM; nN = N / BM; nwg = nM * nN; G = G_; c = c_; mode = (mode_ == 1 && G_ == 256 && nwg == 512) ? 1 : 0; }
    __device__ bool next(int i, Unit& u) const {
        int wgid;
        if (mode == 1) {
            if (c >= 128) { if (i >= 3) return false; wgid = (c - 128) * 3 + i; } else { if (i >= 1) return false; wgid = 384 + c; }
        } else {
            const long L = (long)i * G + c; if (L >= nwg) return false;
            wgid = (int)L; { const int q = nwg / NXCD, r = nwg % NXCD, xcd = wgid % NXCD, off = wgid / NXCD; wgid = (xcd < r ? xcd * (q + 1) : r * (q + 1) + (xcd - r) * q) + off; }
        }
        const int nig = WGM * nN, gid = wgid / nig, fm = gid * WGM, gsz = (nM - fm) < WGM ? (nM - fm) : WGM;
        u.pm = fm + ((wgid % nig) % gsz); u.pn = (wgid % nig) / gsz; return true;
    }
};

template <class Epi>
__device__ __forceinline__ void gemm_phase(const int tid_l, const int bid_l, LAS unsigned char* lds, const Gemm g, const Epi& E) {
    StaticOrder S; S.init(g.M, g.N, (int)gridDim.x, bid_l, g.mode);
    const int tid = tid_l, wid = __builtin_amdgcn_readfirstlane(tid >> 6), lane = tid & 63, wr = wid >> 2, wc = wid & 3, fr = lane & 15, fq = lane >> 4;
    const int K = g.K, nt = K / BK, lda = g.lda;
    unsigned voffA[2], voffB[2];
#pragma unroll
    for (int i = 0; i < 2; ++i) { int R, C; stage_rc(tid * 16 + i * 8192, R, C);
        voffA[i] = (unsigned)(R * lda + C) * 2u; voffB[i] = (unsigned)(R * K + C) * 2u; }
    const size_t kstep = (size_t)(BK * 2);
    const size_t hstepA = (size_t)HALF * lda * 2, hstepB = (size_t)HALF * K * 2;
    const size_t tstepB = 2 * hstepB;
    const unsigned ldsw = (unsigned)wid * 1024u;
    const int aoff = lds_byte(wr * 64 + fr, fq * 8), boff = lds_byte(wc * 32 + fr, fq * 8);
#define PG8_ABASE(pm) ((const char*)g.A + ((size_t)(pm) * 256 + (size_t)((pm) >> 4) * g.gap) * (size_t)lda * 2)
#define PG8_SA(b, h) (((b) * 2 + (h)) * HTB)
#define PG8_SB(b, h) ((4 + (b) * 2 + (h)) * HTB)
#define PG8_STAGE(bufoff, gbase, voff) do { _Pragma("unroll") for (int _i = 0; _i < 2; ++_i) \
        __builtin_amdgcn_global_load_lds((const unsigned*)((const char*)(gbase) + (voff)[_i]), (LAS unsigned*)(lds + (bufoff) + ldsw + _i * 8192), 16, 0, 0); } while (0)
#define PG8_LDA(dst, b, h) do { _Pragma("unroll") for (int m = 0; m < 4; ++m) _Pragma("unroll") for (int k = 0; k < 2; ++k) dst[m][k] = *(const LAS bf16x8*)(lds + PG8_SA(b, h) + aoff + m * 2048 + k * 1024); } while (0)
#define PG8_LDB(dst, b, h) do { _Pragma("unroll") for (int n = 0; n < 2; ++n) _Pragma("unroll") for (int k = 0; k < 2; ++k) dst[n][k] = *(const LAS bf16x8*)(lds + PG8_SB(b, h) + boff + n * 2048 + k * 1024); } while (0)
#define PG8_MMA(ai, bj, At, Bt) do { __builtin_amdgcn_s_setprio(1); _Pragma("unroll") for (int m = 0; m < 4; ++m) _Pragma("unroll") for (int n = 0; n < 2; ++n) _Pragma("unroll") for (int k = 0; k < 2; ++k) \
        acc[ai][bj][m][n] = __builtin_amdgcn_mfma_f32_16x16x32_bf16(Bt[n][k], At[m][k], acc[ai][bj][m][n], 0, 0, 0); __builtin_amdgcn_s_setprio(0); } while (0)
#define PG8_WAIT_V(n) asm volatile("s_waitcnt vmcnt(" #n ")" ::: "memory")
#define PG8_WAIT_L(n) asm volatile("s_waitcnt lgkmcnt(" #n ")" ::: "memory")
#define PG8_BAR __builtin_amdgcn_s_barrier()
#define PG8_SCHED __builtin_amdgcn_sched_barrier(0)
    Unit cur, nxt; int ui = 0;
    if (!S.next(0, cur)) return;
    f32x4 acc[2][2][4][2];
#pragma unroll
    for (int a = 0; a < 2; ++a)
#pragma unroll
        for (int b = 0; b < 2; ++b)
#pragma unroll
            for (int m = 0; m < 4; ++m)
#pragma unroll
                for (int n = 0; n < 2; ++n) acc[a][b][m][n] = (f32x4){0.f, 0.f, 0.f, 0.f};
    bf16x8 At[4][2], B0[2][2], B1[2][2];
    const char* cA = PG8_ABASE(cur.pm); const char* cB = (const char*)g.Bt + (size_t)cur.pn * tstepB;
    PG8_STAGE(PG8_SB(0, 0), cB, voffB); PG8_STAGE(PG8_SA(0, 0), cA, voffA); PG8_STAGE(PG8_SB(0, 1), cB + hstepB, voffB); PG8_STAGE(PG8_SA(0, 1), cA + hstepA, voffA);
    if (wr == 1) PG8_BAR;
    PG8_WAIT_V(4); PG8_BAR;
    PG8_STAGE(PG8_SB(1, 0), cB + kstep, voffB); PG8_STAGE(PG8_SA(1, 0), cA + kstep, voffA); PG8_STAGE(PG8_SB(1, 1), cB + hstepB + kstep, voffB);
    PG8_WAIT_V(6); PG8_BAR;
    for (;;) {
        const bool has_next = S.next(ui + 1, nxt);
        const char* nA = has_next ? PG8_ABASE(nxt.pm) : cA; const char* nB = has_next ? (const char*)g.Bt + (size_t)nxt.pn * tstepB : cB;
        for (int t = 0; t < nt; t += 2) {
            const bool last = (t == nt - 2);
            const char* a1 = cA + (size_t)(t + 1) * kstep;
            const char* a2 = last ? nA : cA + (size_t)(t + 2) * kstep; const char* b2 = last ? nB : cB + (size_t)(t + 2) * kstep;
            const char* a3 = a2 + kstep; const char* b3 = b2 + kstep;
            PG8_LDB(B0, 0, 0); PG8_SCHED; PG8_LDA(At, 0, 0); PG8_STAGE(PG8_SA(1, 1), a1 + hstepA, voffA);
            PG8_WAIT_L(8); PG8_BAR; PG8_WAIT_L(0); PG8_MMA(0, 0, At, B0); PG8_BAR; PG8_SCHED;
            PG8_LDB(B1, 0, 1); PG8_STAGE(PG8_SB(0, 0), b2, voffB);
            PG8_BAR; PG8_WAIT_L(0); PG8_MMA(0, 1, At, B1); PG8_BAR;
            PG8_LDA(At, 0, 1); PG8_STAGE(PG8_SA(0, 0), a2, voffA);
            PG8_BAR; PG8_WAIT_L(0); PG8_MMA(1, 0, At, B0); PG8_BAR; PG8_SCHED;
            PG8_STAGE(PG8_SB(0, 1), b2 + hstepB, voffB);
            PG8_WAIT_V(6); PG8_BAR; PG8_MMA(1, 1, At, B1); PG8_BAR;
            PG8_LDB(B0, 1, 0); PG8_SCHED; PG8_LDA(At, 1, 0); PG8_STAGE(PG8_SA(0, 1), a2 + hstepA, voffA);
            PG8_WAIT_L(8); PG8_BAR; PG8_WAIT_L(0); PG8_MMA(0, 0, At, B0); PG8_BAR; PG8_SCHED;
            PG8_LDB(B1, 1, 1); PG8_STAGE(PG8_SB(1, 0), b3, voffB);
            PG8_BAR; PG8_WAIT_L(0); PG8_MMA(0, 1, At, B1); PG8_BAR;
            PG8_LDA(At, 1, 1); PG8_STAGE(PG8_SA(1, 0), a3, voffA);
            PG8_BAR; PG8_WAIT_L(0); PG8_MMA(1, 0, At, B0); PG8_BAR; PG8_SCHED;
            PG8_STAGE(PG8_SB(1, 1), b3 + hstepB, voffB);
            PG8_WAIT_V(6); PG8_BAR; PG8_MMA(1, 1, At, B1); PG8_BAR;
        }
        E(acc, cur, wr, wc, fr, fq);
        if (!has_next) break;
#pragma unroll
        for (int a = 0; a < 2; ++a)
#pragma unroll
            for (int b = 0; b < 2; ++b)
#pragma unroll
                for (int m = 0; m < 4; ++m)
#pragma unroll
                    for (int n = 0; n < 2; ++n) acc[a][b][m][n] = (f32x4){0.f, 0.f, 0.f, 0.f};
        cur = nxt; cA = nA; cB = nB; ++ui;
    }
    PG8_WAIT_V(0);
    if (wr == 0) PG8_BAR;
    PG8_BAR;
#undef PG8_ABASE
#undef PG8_SA
#undef PG8_SB
#undef PG8_STAGE
#undef PG8_LDA
#undef PG8_LDB
#undef PG8_MMA
#undef PG8_WAIT_V
#undef PG8_WAIT_L
#undef PG8_BAR
#undef PG8_SCHED
}
}
using pg8::Unit; using pg8::Gemm;

#define EPI_SIG const f32x4 (&acc)[2][2][4][2], const Unit& u, int wr, int wc, int fr, int fq
#define EPI_LOOP_AM _Pragma("unroll") for (int ai = 0; ai < 2; ++ai) _Pragma("unroll") for (int m = 0; m < 4; ++m)
#define EPI_LOOP_BN _Pragma("unroll") for (int bj = 0; bj < 2; ++bj) _Pragma("unroll") for (int n = 0; n < 2; ++n)
#define EPI_ROW (u.pm * 256 + ai * 128 + wr * 64 + m * 16 + fr)
#define EPI_COL (u.pn * 256 + bj * 128 + wc * 32 + n * 16 + 4 * fq)

struct EpiBf16 {
    bf16_t* O; int ldc;
    __device__ __forceinline__ void operator()(EPI_SIG) const {
        EPI_LOOP_AM { const size_t ro = (size_t)EPI_ROW * ldc;
#pragma unroll
            for (int bj = 0; bj < 2; ++bj) { const int c = u.pn * 256 + bj * 128 + wc * 32 + 8 * fq; const u32x2 lo = pk4(acc[ai][bj][m][0]), hi = pk4(acc[ai][bj][m][1]);
                *(u32x4*)(O + ro + c) = (u32x4){lo.x, lo.y, hi.x, hi.y}; }
            asm volatile("" ::: "memory"); }
    }
};
struct EpiLora1 {
    bf16_t* O;
    __device__ __forceinline__ void operator()(EPI_SIG) const {
        EPI_LOOP_AM { const size_t ro = (size_t)EPI_ROW * 256; EPI_LOOP_BN { f32x4 v = acc[ai][bj][m][n];
            if (bj == 1) { for (int i = 0; i < 4; ++i) v[i] = sigmoidf_(v[i]); }
            else if (wc < 2) { for (int i = 0; i < 4; ++i) v[i] = 1.f - 2.f / (1.f + __expf(2.f * v[i])); }
            *(u32x2*)(O + ro + EPI_COL) = pk4(v); } asm volatile("" ::: "memory"); }
    }
};
struct EpiLora2 {
    float* Dd; bf16_t* Aa; bf16_t* Gg; const float* w0; const float* a0;
    __device__ __forceinline__ void operator()(EPI_SIG) const {
        const int sect = u.pn >> 2;
        if (sect == 0) {
            EPI_LOOP_AM { const size_t ro = (size_t)EPI_ROW * 1024; EPI_LOOP_BN { const int c = EPI_COL & 1023; f32x4 v = acc[ai][bj][m][n] + *(const f32x4*)(w0 + c);
#pragma unroll
                for (int i = 0; i < 4; ++i) { const float w = -softplusf_(-v[i]) - 0.5f; v[i] = __expf(-__expf(w)); }
                *(f32x4*)(Dd + ro + c) = v; asm volatile("" ::: "memory"); } }
        } else if (sect == 1) {
            EPI_LOOP_AM { const size_t ro = (size_t)EPI_ROW * 1024; EPI_LOOP_BN { const int c = EPI_COL & 1023; f32x4 v = acc[ai][bj][m][n] + *(const f32x4*)(a0 + c);
#pragma unroll
                for (int i = 0; i < 4; ++i) v[i] = sigmoidf_(v[i]);
                *(u32x2*)(Aa + ro + c) = pk4(v); asm volatile("" ::: "memory"); } }
        } else {
            EPI_LOOP_AM { const size_t ro = (size_t)EPI_ROW * 1024; EPI_LOOP_BN { const int c = EPI_COL & 1023; *(u32x2*)(Gg + ro + c) = pk4(acc[ai][bj][m][n]); } asm volatile("" ::: "memory"); }
        }
    }
};
struct EpiResid {
    const float* hin; float* hout; const float* bias;
    __device__ __forceinline__ void operator()(EPI_SIG) const {
        EPI_LOOP_AM { const size_t ro = (size_t)EPI_ROW * 1024;
#pragma unroll
            for (int bj = 0; bj < 2; ++bj) { const int c = u.pn * 256 + bj * 128 + wc * 32 + 8 * fq;
                f32x4 v0 = acc[ai][bj][m][0] + *(const f32x4*)(hin + ro + c), v1 = acc[ai][bj][m][1] + *(const f32x4*)(hin + ro + c + 4);
                if (bias) { v0 = v0 + *(const f32x4*)(bias + c); v1 = v1 + *(const f32x4*)(bias + c + 4); }
                *(f32x4*)(hout + ro + c) = v0; *(f32x4*)(hout + ro + c + 4) = v1; }
            asm volatile("" ::: "memory"); }
    }
};
struct EpiSwiglu {
    bf16_t* H;
    __device__ __forceinline__ void operator()(EPI_SIG) const {
        EPI_LOOP_AM { const size_t ro = (size_t)EPI_ROW * FFH; const int c = u.pn * 128 + wc * 32 + 8 * fq; f32x4 v[2];
#pragma unroll
            for (int n = 0; n < 2; ++n) { const f32x4 g = acc[ai][0][m][n], up = acc[ai][1][m][n];
#pragma unroll
                for (int i = 0; i < 4; ++i) v[n][i] = g[i] * __builtin_amdgcn_rcpf(1.f + __expf(-g[i])) * up[i]; }
            const u32x2 lo = pk4(v[0]), hi = pk4(v[1]);
            *(u32x4*)(H + ro + c) = (u32x4){lo.x, lo.y, hi.x, hi.y}; asm volatile("" ::: "memory"); }
    }
};
struct EpiQKV {
    bf16_t* Q; bf16_t* Kb; bf16_t* Vb; const float* bias; const float* cosT; const float* sinT;
    __device__ __forceinline__ void operator()(EPI_SIG) const {
        EPI_LOOP_AM { const int row = EPI_ROW;
#pragma unroll
            for (int n = 0; n < 2; ++n) { const int d1 = n * 16 + 4 * fq; const f32x4 t1r = acc[ai][0][m][n], t2r = acc[ai][1][m][n];
                if (u.pn < 4 || wc < 2) {
                    const bool isq = u.pn < 4; const int head = isq ? 4 * u.pn + wc : wc; const int c1 = head * 64 + d1; const int bo = isq ? c1 : 1024 + c1;
                    const f32x4 t1 = t1r + *(const f32x4*)(bias + bo), t2 = t2r + *(const f32x4*)(bias + bo + 32);
                    const f32x4 cs = *(const f32x4*)(cosT + (size_t)row * 32 + d1), sn = *(const f32x4*)(sinT + (size_t)row * 32 + d1);
                    const f32x4 o1 = t1 * cs - t2 * sn, o2 = t2 * cs + t1 * sn;
                    bf16_t* dst = isq ? Q + (size_t)row * 1024 + c1 : Kb + (size_t)row * 128 + c1;
                    *(u32x2*)dst = pk4(o1); *(u32x2*)(dst + 32) = pk4(o2);
                } else {
                    const int j = (wc - 2) * 32 + d1;
                    const f32x4 v0 = t1r + *(const f32x4*)(bias + 1152 + j), v1 = t2r + *(const f32x4*)(bias + 1216 + j);
                    *(u32x2*)(Vb + (size_t)row * 128 + j) = pk4(v0); *(u32x2*)(Vb + (size_t)row * 128 + 64 + j) = pk4(v1);
                } } asm volatile("" ::: "memory"); }
    }
};
struct EpiSGUin {
    bf16_t* U; bf16_t* V; const float* bias; float* stats;
    __device__ __forceinline__ void operator()(EPI_SIG) const {
        const bool isv = u.pn >= 8;
        EPI_LOOP_AM { const int row = EPI_ROW; float s1 = 0.f, s2 = 0.f;
#pragma unroll
            for (int bj = 0; bj < 2; ++bj) { const int c = u.pn * 256 + bj * 128 + wc * 32 + 8 * fq; f32x4 v[2];
#pragma unroll
                for (int n = 0; n < 2; ++n) { const f32x4 t = acc[ai][bj][m][n] + *(const f32x4*)(bias + c + 4 * n);
                    const f32x2 a = gelu_pk((f32x2){t[0], t[1]}), b = gelu_pk((f32x2){t[2], t[3]}); v[n] = (f32x4){a.x, a.y, b.x, b.y};
                    s1 += (v[n][0] + v[n][1]) + (v[n][2] + v[n][3]); s2 += (v[n][0] * v[n][0] + v[n][1] * v[n][1]) + (v[n][2] * v[n][2] + v[n][3] * v[n][3]); }
                const u32x2 lo = pk4(v[0]), hi = pk4(v[1]); const u32x4 w4 = {lo.x, lo.y, hi.x, hi.y};
                if (isv) *(u32x4*)(V + (size_t)row * 2048 + (c - 2048)) = w4; else *(u32x4*)(U + (size_t)row * 2048 + c) = w4; }
            if (isv) { s1 = xrow_sum(s1); s2 = xrow_sum(s2);
                if (fq == 0) *(f32x2*)(stats + (size_t)row * 64 + (u.pn - 8) * 8 + wc * 2) = (f32x2){s1, s2}; } asm volatile("" ::: "memory"); }
    }
};

template <class F>
__device__ __forceinline__ void cvt_tiles(const int tid_l, const int bid_l, bf16_t* dst, int N, int K, F f, LAS float* scr, int rot) {
    const int tid = tid_l, ntn = N / 64, ntk = K / 64, ntile = ntn * ntk;
    const int i = tid & 63, j = tid >> 6, nn = tid >> 3, c = tid & 7;
    for (int t = (int)((bid_l + rot) % gridDim.x); t < ntile; t += gridDim.x) {
        const int n0 = (t % ntn) * 64, k0 = (t / ntn) * 64;
#pragma unroll
        for (int pp = 0; pp < 8; ++pp) { const int kk = pp * 8 + j; scr[kk * 65 + i] = f(n0 + i, k0 + kk); }
        __syncthreads();
        const LAS float* s = scr + (8 * c) * 65 + nn;
        u32x4 o; o.x = pk2(s[0], s[65]); o.y = pk2(s[130], s[195]); o.z = pk2(s[260], s[325]); o.w = pk2(s[390], s[455]);
        *(u32x4*)(dst + (size_t)(n0 + nn) * K + k0 + 8 * c) = o;
        __syncthreads();
    }
}
__device__ __forceinline__ int perm32(int rho) { const int n = rho >> 4, i = rho & 15; return 8 * (i >> 2) + 4 * n + (i & 3); }
struct FPlain { const float* W; int N; __device__ __forceinline__ float operator()(int n, int k) const { return W[(size_t)k * N + n]; } };
struct FPlainP { const float* W; int N; __device__ __forceinline__ float operator()(int n, int k) const { return W[(size_t)k * N + (n & ~31) + perm32(n & 31)]; } };
struct FFfnIn { const float* W; __device__ __forceinline__ float operator()(int n, int k) const { const int pn = n >> 8, s = n & 255, j = s & 127; const int col = (s < 128 ? 0 : 2816) + 128 * pn + (j & ~31) + perm32(j & 31); return W[(size_t)k * 5632 + col]; } };
struct FLora1 { const float *w1, *a1, *g1, *mu; __device__ __forceinline__ float operator()(int n, int k) const {
    const float* W; int ld, col, c; if (n < 64) { W = w1; ld = 64; col = n; c = 1; } else if (n < 128) { W = a1; ld = 64; col = n - 64; c = 4; } else { W = g1; ld = 128; col = n - 128; c = 5; }
    const int kk = k & 1023; const float m = mu[c * 1024 + kk]; return (k < 1024 ? m : 1.f - m) * W[(size_t)kk * ld + col]; } };
struct FLora2 { const float *w2, *a2, *g2; __device__ __forceinline__ float operator()(int n, int k) const {
    if (n < 1024) return k < 64 ? w2[(size_t)k * 1024 + n] : 0.f;
    if (n < 2048) return (k >= 64 && k < 128) ? a2[(size_t)(k - 64) * 1024 + (n - 1024)] : 0.f;
    return k >= 128 ? g2[(size_t)(k - 128) * 1024 + (n - 2048)] : 0.f; } };
struct FQkv { const float* W; __device__ __forceinline__ float operator()(int n, int k) const {
    const int pn = n >> 8, s = n & 255, hi = s >> 7, j = s & 127; int col;
    if (pn < 4) col = (4 * pn + (j >> 5)) * 64 + 32 * hi + (j & 31);
    else if (j < 64) col = 1024 + (j >> 5) * 64 + 32 * hi + (j & 31);
    else col = 1152 + 64 * hi + (j - 64);
    return W[(size_t)k * 1280 + col]; } };
struct FGlaIn { const float* W; __device__ __forceinline__ float operator()(int n, int k) const { const int c = (n & ~31) + perm32(n & 31); return c < 3088 ? W[(size_t)k * 3088 + c] : 0.f; } };

template <class F>
__device__ __forceinline__ void cvt_item_wave(bf16_t* dst, int N, int K, F f, LAS float* scr, int it, int lane) {
    const int nblk = N / 32, kb = it / nblk, nb = it - kb * nblk, k0 = 64 * kb, n0 = 32 * nb, c = lane & 7;
#pragma unroll 8
    for (int i = 0; i < 32; ++i) { const int kk = 2 * i + (lane >> 5); scr[kk * 33 + (lane & 31)] = f(n0 + (lane & 31), k0 + kk); }
    asm volatile("s_waitcnt lgkmcnt(0)" ::: "memory");
#pragma unroll
    for (int j = 0; j < 4; ++j) { const int n = (lane >> 3) + 8 * j; const LAS float* sp = scr + (8 * c) * 33 + n;
        u32x4 o; o.x = pk2(sp[0 * 33], sp[1 * 33]); o.y = pk2(sp[2 * 33], sp[3 * 33]); o.z = pk2(sp[4 * 33], sp[5 * 33]); o.w = pk2(sp[6 * 33], sp[7 * 33]);
        *(u32x4*)(dst + (size_t)(n0 + n) * K + k0 + 8 * c) = o; }
    asm volatile("s_waitcnt lgkmcnt(0)" ::: "memory");
}
struct CvtPend { bf16_t* dst; int K, n0, k0; float v[32]; };
template <class F>
__device__ __forceinline__ void cvt_issue(CvtPend& pd, bf16_t* dst, int N, int K, F f, int it, int lane) {
    const int nblk = N / 32, kb = it / nblk, nb = it - kb * nblk; pd.dst = dst; pd.K = K; pd.k0 = 64 * kb; pd.n0 = 32 * nb;
#pragma unroll
    for (int i = 0; i < 32; ++i) pd.v[i] = f(pd.n0 + (lane & 31), pd.k0 + 2 * i + (lane >> 5));
}
__device__ __forceinline__ void cvt_finish(const CvtPend& pd, LAS float* scr, int lane) {
    const int c = lane & 7;
#pragma unroll
    for (int i = 0; i < 32; ++i) scr[(2 * i + (lane >> 5)) * 33 + (lane & 31)] = pd.v[i];
    asm volatile("s_waitcnt lgkmcnt(0)" ::: "memory");
#pragma unroll
    for (int j = 0; j < 4; ++j) { const int n = (lane >> 3) + 8 * j; const LAS float* sp = scr + (8 * c) * 33 + n;
        u32x4 o; o.x = pk2(sp[0 * 33], sp[1 * 33]); o.y = pk2(sp[2 * 33], sp[3 * 33]); o.z = pk2(sp[4 * 33], sp[5 * 33]); o.w = pk2(sp[6 * 33], sp[7 * 33]);
        *(u32x4*)(pd.dst + (size_t)(pd.n0 + n) * pd.K + pd.k0 + 8 * c) = o; }
    asm volatile("s_waitcnt lgkmcnt(0)" ::: "memory");
}
constexpr int DEF_FFN = 2816 + 1408, DEF_TOTAL = 4 * DEF_FFN + 640 + 512 + 2048 + 1024 + 1664 + 512;
__device__ __forceinline__ void cvt_deferred_item(const LAS unsigned long long* ptab, unsigned char* ws, LAS float* scr, int g, int lane) {
    int r = g;
    if (r < 4 * DEF_FFN) { const int l = r / DEF_FFN; r -= l * DEF_FFN;
        if (r < 2816) cvt_item_wave((bf16_t*)(ws + W_FFN_IN) + (size_t)l * 5632 * 1024, 5632, 1024, FFfnIn{inp(ptab, 4) + (size_t)l * 1024 * 5632}, scr, r, lane);
        else cvt_item_wave((bf16_t*)(ws + W_FFN_OUT) + (size_t)l * 1024 * 2816, 1024, 2816, FPlainP{inp(ptab, 5) + (size_t)l * 2816 * 1024, 1024}, scr, r - 2816, lane);
        return; }
    r -= 4 * DEF_FFN;
    if (r < 640) { cvt_item_wave((bf16_t*)(ws + W_QKV), 1280, 1024, FQkv{inp(ptab, 23)}, scr, r, lane); return; } r -= 640;
    if (r < 512) { cvt_item_wave((bf16_t*)(ws + W_SWO), 1024, 1024, FPlainP{inp(ptab, 26), 1024}, scr, r, lane); return; } r -= 512;
    if (r < 2048) { cvt_item_wave((bf16_t*)(ws + W_SGIN), 4096, 1024, FPlainP{inp(ptab, 28), 4096}, scr, r, lane); return; } r -= 2048;
    if (r < 1024) { cvt_item_wave((bf16_t*)(ws + W_SGO), 1024, 2048, FPlainP{inp(ptab, 34), 1024}, scr, r, lane); return; } r -= 1024;
    if (r < 1664) { cvt_item_wave((bf16_t*)(ws + W_GLIN), 3328, 1024, FGlaIn{inp(ptab, 36)}, scr, r, lane); return; } r -= 1664;
    if (r < 512) cvt_item_wave((bf16_t*)(ws + W_GLO), 1024, 1024, FPlainP{inp(ptab, 40), 1024}, scr, r, lane);
}
__device__ __forceinline__ void cvt_deferred_issue(CvtPend& pd, const LAS unsigned long long* ptab, unsigned char* ws, int g, int lane) {
    int r = g;
    if (r < 4 * DEF_FFN) { const int l = r / DEF_FFN; r -= l * DEF_FFN;
        if (r < 2816) cvt_issue(pd, (bf16_t*)(ws + W_FFN_IN) + (size_t)l * 5632 * 1024, 5632, 1024, FFfnIn{inp(ptab, 4) + (size_t)l * 1024 * 5632}, r, lane);
        else cvt_issue(pd, (bf16_t*)(ws + W_FFN_OUT) + (size_t)l * 1024 * 2816, 1024, 2816, FPlainP{inp(ptab, 5) + (size_t)l * 2816 * 1024, 1024}, r - 2816, lane);
        return; }
    r -= 4 * DEF_FFN;
    if (r < 640) { cvt_issue(pd, (bf16_t*)(ws + W_QKV), 1280, 1024, FQkv{inp(ptab, 23)}, r, lane); return; } r -= 640;
    if (r < 512) { cvt_issue(pd, (bf16_t*)(ws + W_SWO), 1024, 1024, FPlainP{inp(ptab, 26), 1024}, r, lane); return; } r -= 512;
    if (r < 2048) { cvt_issue(pd, (bf16_t*)(ws + W_SGIN), 4096, 1024, FPlainP{inp(ptab, 28), 4096}, r, lane); return; } r -= 2048;
    if (r < 1024) { cvt_issue(pd, (bf16_t*)(ws + W_SGO), 1024, 2048, FPlainP{inp(ptab, 34), 1024}, r, lane); return; } r -= 1024;
    if (r < 1664) { cvt_issue(pd, (bf16_t*)(ws + W_GLIN), 3328, 1024, FGlaIn{inp(ptab, 36)}, r, lane); return; } r -= 1664;
    if (r < 512) cvt_issue(pd, (bf16_t*)(ws + W_GLO), 1024, 1024, FPlainP{inp(ptab, 40), 1024}, r, lane);
}
__device__ __forceinline__ void phase_prep(const int tid_l, const int bid_l, const LAS unsigned long long* ptab, unsigned char* ws, LAS unsigned char* lds) {
    LAS float* scr = (LAS float*)lds;
    int rot = 0;
    for (int l = 0; l < 4; ++l) {
    }
    for (int c = 0; c < 3; ++c) { cvt_tiles(tid_l, bid_l, (bf16_t*)(ws + W_RKV) + (size_t)c * 1024 * 1024, 1024, 1024, FPlainP{inp(ptab, 8) + (size_t)c * 1024 * 1024, 1024}, scr, rot); }
    cvt_tiles(tid_l, bid_l, (bf16_t*)(ws + W_L1), 256, 2048, FLora1{inp(ptab, 10), inp(ptab, 13), inp(ptab, 15), inp(ptab, 7)}, scr, rot); rot += 128;
    cvt_tiles(tid_l, bid_l, (bf16_t*)(ws + W_L2), 3072, 256, FLora2{inp(ptab, 11), inp(ptab, 14), inp(ptab, 16)}, scr, rot); rot += 192;
    cvt_tiles(tid_l, bid_l, (bf16_t*)(ws + W_RWO), 1024, 1024, FPlainP{inp(ptab, 22), 1024}, scr, rot);
    const size_t gt = (size_t)bid_l * NTHR + tid_l, gn = (size_t)gridDim.x * NTHR;
    { bf16_t* d = (bf16_t*)(ws + W_SGS); const float* w = inp(ptab, 32);
      for (size_t i = gt; i < (size_t)16 * 128 * 128; i += gn) { const int s = (int)(i & 127), t = (int)((i >> 7) & 127); d[i] = f2bf(s <= t ? w[i] : 0.f); } }
    { float* ct = (float*)(ws + T_COS); float* st = (float*)(ws + T_SIN); const int* pos = (const int*)inp(ptab, 1);
      for (size_t i = gt; i < (size_t)MTOK * 32; i += gn) { const int d = (int)(i & 31); const float inv = powf(10000.f, -(float)(2 * d) / 64.f); const float ang = (float)pos[i >> 5] * inv; ct[i] = cosf(ang); st[i] = sinf(ang); } }
#ifdef ZERO_FILL
    { u32x4* z = (u32x4*)(ws + SLOT0); const size_t nz = (6 * SLOT) / 16; for (size_t i = gt; i < nz; i += gn) z[i] = (u32x4){0u, 0u, 0u, 0u};
      u32x4* zo = (u32x4*)inp(ptab, 41); for (size_t i = gt; i < (size_t)MTOK * 1024 / 4; i += gn) zo[i] = (u32x4){0u, 0u, 0u, 0u}; }
#endif
}

__device__ __forceinline__ void phase_norm(const int tid_l, const int bid_l, const float* h, const float* g, bf16_t* out) {
    const int lane = tid_l & 63, gw = bid_l * 8 + (tid_l >> 6), ngw = gridDim.x * 8;
    f32x4 gv[4];
#pragma unroll
    for (int j = 0; j < 4; ++j) gv[j] = *(const f32x4*)(g + 4 * lane + 256 * j);
    for (int row = 2 * gw; row < MTOK; row += 2 * ngw) {
        f32x4 v[2][4]; float ss[2] = {0.f, 0.f};
#pragma unroll
        for (int r = 0; r < 2; ++r)
#pragma unroll
            for (int j = 0; j < 4; ++j) v[r][j] = *(const f32x4*)(h + (size_t)(row + r) * 1024 + 4 * lane + 256 * j);
#pragma unroll
        for (int r = 0; r < 2; ++r)
#pragma unroll
            for (int j = 0; j < 4; ++j) ss[r] += (v[r][j][0] * v[r][j][0] + v[r][j][1] * v[r][j][1]) + (v[r][j][2] * v[r][j][2] + v[r][j][3] * v[r][j][3]);
#pragma unroll
        for (int r = 0; r < 2; ++r) { const float rstd = rsqrtf(wave_sum(ss[r]) * (1.f / 1024.f) + EPS);
#pragma unroll
            for (int j = 0; j < 4; ++j) *(u32x2*)(out + (size_t)(row + r) * 1024 + 4 * lane + 256 * j) = pk4(v[r][j] * rstd * gv[j]); }
    }
}
__device__ __forceinline__ void phase_final(const int tid_l, const int bid_l, float* h, const float* g) {
    const int lane = tid_l & 63, gw = bid_l * 8 + (tid_l >> 6), ngw = gridDim.x * 8;
    f32x4 gv[4];
#pragma unroll
    for (int j = 0; j < 4; ++j) gv[j] = *(const f32x4*)(g + 4 * lane + 256 * j);
    for (int row = 2 * gw; row < MTOK; row += 2 * ngw) {
        f32x4 v[2][4]; float ss[2] = {0.f, 0.f};
#pragma unroll
        for (int r = 0; r < 2; ++r)
#pragma unroll
            for (int j = 0; j < 4; ++j) v[r][j] = *(const f32x4*)(h + (size_t)(row + r) * 1024 + 4 * lane + 256 * j);
#pragma unroll
        for (int r = 0; r < 2; ++r)
#pragma unroll
            for (int j = 0; j < 4; ++j) ss[r] += (v[r][j][0] * v[r][j][0] + v[r][j][1] * v[r][j][1]) + (v[r][j][2] * v[r][j][2] + v[r][j][3] * v[r][j][3]);
#pragma unroll
        for (int r = 0; r < 2; ++r) { const float rstd = rsqrtf(wave_sum(ss[r]) * (1.f / 1024.f) + EPS);
#pragma unroll
            for (int j = 0; j < 4; ++j) __builtin_nontemporal_store(v[r][j] * rstd * gv[j], (f32x4*)(h + (size_t)(row + r) * 1024 + 4 * lane + 256 * j)); }
    }
}
__device__ __forceinline__ void phase_rw_norm(const int tid_l, const int bid_l, const float* x, const float* g, const float* mu, bf16_t* hnG, bf16_t* xr, bf16_t* xk, bf16_t* xv) {
    const int lane = tid_l & 63, gw = bid_l * 8 + (tid_l >> 6), ngw = gridDim.x * 8;
    for (int row = gw; row < MTOK; row += ngw) {
        const int b = row >> 12, s = row & 4095;
        f32x4 v[4], pv[4]; float ss = 0.f, ps = 0.f;
#pragma unroll
        for (int j = 0; j < 4; ++j) { v[j] = *(const f32x4*)(x + (size_t)row * 1024 + 4 * lane + 256 * j); ss += (v[j][0] * v[j][0] + v[j][1] * v[j][1]) + (v[j][2] * v[j][2] + v[j][3] * v[j][3]);
            pv[j] = s > 0 ? *(const f32x4*)(x + (size_t)(row - 1) * 1024 + 4 * lane + 256 * j) : (f32x4){0.f, 0.f, 0.f, 0.f}; ps += (pv[j][0] * pv[j][0] + pv[j][1] * pv[j][1]) + (pv[j][2] * pv[j][2] + pv[j][3] * pv[j][3]); }
        const float rstd = rsqrtf(wave_sum(ss) * (1.f / 1024.f) + EPS), prstd = rsqrtf(wave_sum(ps) * (1.f / 1024.f) + EPS);
#pragma unroll
        for (int j = 0; j < 4; ++j) { const int c = 4 * lane + 256 * j; const f32x4 gv = *(const f32x4*)(g + c);
            const f32x4 hn = v[j] * rstd * gv, hp = pv[j] * prstd * gv, xx = hp - hn;
            *(u32x2*)(hnG + (size_t)(row + b + 1) * 1024 + c) = pk4(hn);
            if (s == 0) *(u32x2*)(hnG + (size_t)(row + b) * 1024 + c) = (u32x2){0u, 0u};
            *(u32x2*)(xr + (size_t)row * 1024 + c) = pk4(hn + xx * *(const f32x4*)(mu + 0 * 1024 + c));
            *(u32x2*)(xk + (size_t)row * 1024 + c) = pk4(hn + xx * *(const f32x4*)(mu + 2 * 1024 + c));
            *(u32x2*)(xv + (size_t)row * 1024 + c) = pk4(hn + xx * *(const f32x4*)(mu + 3 * 1024 + c)); }
    }
}

#ifndef SCAN_DPP
#define SCAN_DPP 0
#endif
__device__ __forceinline__ float scan_red(float x) { return SCAN_DPP ? dsum16(x) : sum16(x); }
__device__ __forceinline__ void phase_rw_scan(const int tid_l, const int bid_l, const bf16_t* R, const bf16_t* Kk, const bf16_t* V, const bf16_t* Aa, const float* Dd, const float* k_k, const float* k_a, bf16_t* Y, LAS unsigned char* lds, const LAS unsigned long long* ptab, unsigned char* ws) {
    LAS float* buf = (LAS float*)lds;
    LAS float* vbuf = (LAS float*)(lds + 81920);
    LAS float* ybuf = (LAS float*)(lds + 81920 + 8192);
    const int tid = tid_l, lane = tid & 63, w = __builtin_amdgcn_readfirstlane(tid >> 6), rp = lane >> 4, cl = lane & 15;
    const bool is_loader = w >= 4;
    const int lt = tid - 256, lj = (lt >> 4) & 15, lcg = lt & 15;
    LAS float* cscr = (LAS float*)(lds + 98304) + (w >= 4 ? (w - 4) : 0) * (64 * 33);
    const int dlw = bid_l * 4 + (w - 4), dstride = (int)gridDim.x * 4; bool defer = true;
    for (int item = bid_l; item < 256; item += gridDim.x) {
        const int b = item >> 5, h = (item >> 1) & 15, half = item & 1;
        const size_t colb = (size_t)h * 64 + 4 * lcg;
        f32x4 kkv = {0.f, 0.f, 0.f, 0.f}, kav = {0.f, 0.f, 0.f, 0.f};
        if (is_loader) { kkv = *(const f32x4*)(k_k + colb); kav = *(const f32x4*)(k_a + colb); }
        const int r0 = 8 * w + 2 * rp;
        f32x2 a01 = {0.f, 0.f}, a23 = {0.f, 0.f}, b01 = {0.f, 0.f}, b23 = {0.f, 0.f};
        u32x2 lr[2], lk[2], la[2], lv[2]; f32x4 ld[2];
        auto gload = [&](int c) {
#pragma unroll
            for (int q = 0; q < 2; ++q) { const size_t m = (size_t)b * 4096 + c * 32 + lj + 16 * q; const size_t o = m * 1024 + colb;
                lr[q] = *(const u32x2*)(R + o); lk[q] = *(const u32x2*)(Kk + o); la[q] = *(const u32x2*)(Aa + o); ld[q] = *(const f32x4*)(Dd + o);
                if (lcg < 8) lv[q] = *(const u32x2*)(V + m * 1024 + h * 64 + half * 32 + 4 * lcg); } };
        auto lstore = [&](int nbuf) {
#pragma unroll
            for (int q = 0; q < 2; ++q) { const int st = lj + 16 * q; const f32x4 r4 = unpk4(lr[q]), k4 = unpk4(lk[q]), a4 = unpk4(la[q]);
                const f32x4 kx = k4 * kkv; float ssq = (kx[0] * kx[0] + kx[1] * kx[1]) + (kx[2] * kx[2] + kx[3] * kx[3]); ssq = sum16(ssq);
                const f32x4 kk = kx * rsqrtf(fmaxf(ssq, 1e-24f)); const f32x4 nb = -(kk * a4); const f32x4 km = k4 * (1.f + (a4 - 1.f) * kav);
                LAS float* bp = buf + ((nbuf * 32 + st) * 5) * 64 + 4 * lcg;
                *(LAS f32x4*)(bp) = ld[q]; *(LAS f32x4*)(bp + 64) = kk; *(LAS f32x4*)(bp + 128) = nb; *(LAS f32x4*)(bp + 192) = km; *(LAS f32x4*)(bp + 256) = r4;
                if (lcg < 8) *(LAS f32x4*)(vbuf + (nbuf * 32 + st) * 32 + 4 * lcg) = unpk4(lv[q]); } };
        auto ycopy = [&](int c) {
#pragma unroll
            for (int q = 0; q < 2; ++q) if (lcg < 8) { const int st = lj + 16 * q; const size_t m = (size_t)b * 4096 + c * 32 + st; const f32x4 yv = *(const LAS f32x4*)(ybuf + ((c & 1) * 32 + st) * 32 + 4 * lcg);
                *(u32x2*)(Y + m * 1024 + h * 64 + half * 32 + 4 * lcg) = pk4(yv); } };
        __syncthreads();
        if (is_loader) { gload(0); lstore(0); }
        __syncthreads();
        for (int c = 0; c < 128; ++c) {
            if (is_loader) {
                if (c + 1 < 128) gload(c + 1);
                if (c > 0) ycopy(c - 1);
                const int dg = dlw + dstride * (c / 5); const bool ddo = defer && (c % 5) == 0 && dg < DEF_TOTAL;
                CvtPend pd;
                if (ddo) cvt_deferred_issue(pd, ptab, ws, dg, lane);
                if (c + 1 < 128) lstore((c + 1) & 1);
                if (ddo) cvt_finish(pd, cscr, lane);
            } else {
                const int cb = c & 1;
                const LAS float* bp0 = buf + (cb * 32 * 5) * 64 + 4 * cl; const LAS float* vp0 = vbuf + (cb * 32) * 32 + r0;
                f32x4 d4 = *(const LAS f32x4*)(bp0), kk4 = *(const LAS f32x4*)(bp0 + 64), nb4 = *(const LAS f32x4*)(bp0 + 128), km4 = *(const LAS f32x4*)(bp0 + 192), r4 = *(const LAS f32x4*)(bp0 + 256);
                f32x2 vv = *(const LAS f32x2*)(vp0);
#pragma unroll
                for (int jb = 0; jb < 32; jb += 16) {
                    f32x2 ysel = {0.f, 0.f};
#pragma unroll
                    for (int jj = 0; jj < 16; ++jj) {
                        const int j = jb + jj;
                        f32x4 d4n = d4, kk4n = kk4, nb4n = nb4, km4n = km4, r4n = r4; f32x2 vvn = vv;
                        if (j + 1 < 32) { const LAS float* bp = bp0 + (j + 1) * 320;
                            d4n = *(const LAS f32x4*)(bp); kk4n = *(const LAS f32x4*)(bp + 64); nb4n = *(const LAS f32x4*)(bp + 128); km4n = *(const LAS f32x4*)(bp + 192); r4n = *(const LAS f32x4*)(bp + 256);
                            vvn = *(const LAS f32x2*)(vp0 + (j + 1) * 32); }
                        const f32x2 d01 = {d4[0], d4[1]}, d23 = {d4[2], d4[3]}, k01 = {kk4[0], kk4[1]}, k23 = {kk4[2], kk4[3]}, n01 = {nb4[0], nb4[1]}, n23 = {nb4[2], nb4[3]};
                        const f32x2 m01 = {km4[0], km4[1]}, m23 = {km4[2], km4[3]}, q01 = {r4[0], r4[1]}, q23 = {r4[2], r4[3]};
                        f32x2 ta = a01 * k01 + a23 * k23, tb = b01 * k01 + b23 * k23;
                        const float sa0 = sum16(ta[0] + ta[1]), sa1 = sum16(tb[0] + tb[1]);
                        a01 = a01 * d01 + n01 * sa0 + m01 * vv[0]; a23 = a23 * d23 + n23 * sa0 + m23 * vv[0];
                        b01 = b01 * d01 + n01 * sa1 + m01 * vv[1]; b23 = b23 * d23 + n23 * sa1 + m23 * vv[1];
                        ta = a01 * q01 + a23 * q23; tb = b01 * q01 + b23 * q23;
                        const float y0 = sum16(ta[0] + ta[1]), y1 = sum16(tb[0] + tb[1]);
                        if (cl == jj) ysel = (f32x2){y0, y1};
                        d4 = d4n; kk4 = kk4n; nb4 = nb4n; km4 = km4n; r4 = r4n; vv = vvn;
                    }
                    *(LAS f32x2*)(ybuf + (cb * 32 + jb + cl) * 32 + r0) = ysel;
                }
            }
            __syncthreads();
        }
        if (is_loader) { ycopy(127); if (defer) for (int t = 26; dlw + dstride * t < DEF_TOTAL; ++t) cvt_deferred_item(ptab, ws, cscr, dlw + dstride * t, lane); }
        defer = false;
    }
}
__device__ __forceinline__ void phase_rw_post(const int tid_l, const int bid_l, const bf16_t* Y, const bf16_t* R, const bf16_t* Kk, const bf16_t* V, const bf16_t* Aa, const bf16_t* Gg,
                                              const float* k_a, const float* r_k, const float* gn_g, const float* gn_b, bf16_t* Z) {
    const size_t gt = (size_t)bid_l * NTHR + tid_l, gn = (size_t)gridDim.x * NTHR;
    for (size_t i = gt; i < (size_t)MTOK * 256; i += gn) {
        const size_t o = i * 4; const int c = (int)(o & 1023);
        const f32x4 y = unpk4(__builtin_nontemporal_load((const u32x2*)(Y + o))), r = unpk4(__builtin_nontemporal_load((const u32x2*)(R + o))), k = unpk4(__builtin_nontemporal_load((const u32x2*)(Kk + o))), v = unpk4(__builtin_nontemporal_load((const u32x2*)(V + o))), a = unpk4(__builtin_nontemporal_load((const u32x2*)(Aa + o))), g = unpk4(__builtin_nontemporal_load((const u32x2*)(Gg + o)));
        const f32x4 km = k * (1.f + (a - 1.f) * *(const f32x4*)(k_a + c));
        const f32x4 rk = r * km * *(const f32x4*)(r_k + c);
        const float mean = sum16((y[0] + y[1]) + (y[2] + y[3])) * (1.f / 64.f);
        const f32x4 dy = y - mean;
        const float var = sum16((dy[0] * dy[0] + dy[1] * dy[1]) + (dy[2] * dy[2] + dy[3] * dy[3])) * (1.f / 64.f);
        const float bon = sum16((rk[0] + rk[1]) + (rk[2] + rk[3]));
        const f32x4 yn = dy * rsqrtf(var + 64e-5f) * *(const f32x4*)(gn_g + c) + *(const f32x4*)(gn_b + c);
        *(u32x2*)(Z + o) = pk4((yn + bon * v) * g);
    }
}

__device__ __forceinline__ u32x4 ld_coh(const bf16_t* p) {
    const unsigned long long* q = (const unsigned long long*)p;
    const unsigned long long a = __hip_atomic_load(q, __ATOMIC_RELAXED, __HIP_MEMORY_SCOPE_AGENT), b = __hip_atomic_load(q + 1, __ATOMIC_RELAXED, __HIP_MEMORY_SCOPE_AGENT);
    return (u32x4){(unsigned)a, (unsigned)(a >> 32), (unsigned)b, (unsigned)(b >> 32)};
}
__device__ __forceinline__ float ssum16(float v) {
#pragma unroll
    for (int o = 1; o < 16; o <<= 1) v += __shfl_xor(v, o);
    return v;
}
__device__ __forceinline__ float smax16(float v) {
#pragma unroll
    for (int o = 1; o < 16; o <<= 1) v = fmaxf(v, __shfl_xor(v, o));
    return v;
}
__device__ __forceinline__ void phase_sw_att(const int tid_l, const int bid_l, const bf16_t* Q, const bf16_t* Kb, const bf16_t* Vb, const float* sinks, bf16_t* O, LAS unsigned char* lds) {
    LAS bf16_t* Ks = (LAS bf16_t*)lds;
    LAS bf16_t* Vt = (LAS bf16_t*)(lds + 36864);
    LAS bf16_t* Qs = (LAS bf16_t*)(lds + 36864 + 35840);
    LAS bf16_t* Ps = (LAS bf16_t*)(lds + 36864 + 35840 + 18432);
    const int tid = tid_l, lane = tid & 63, w = __builtin_amdgcn_readfirstlane(tid >> 6), fr = lane & 15, fq = lane >> 4, dq = fq * 4 - fr;
    LAS bf16_t* Pw = Ps + w * 16 * 168;
    for (int item = bid_l; item < 512; item += gridDim.x) {
        const int b = item >> 6, n = (item >> 1) & 31, hk = item & 1;
        __syncthreads();
        for (int id = tid; id < 2048; id += NTHR) { const int key = id >> 3, dc = id & 7; const int pos = n * 128 - 128 + key;
            u32x4 kv = {0u, 0u, 0u, 0u};
            if (pos >= 0) kv = *(const u32x4*)(Kb + ((size_t)b * 4096 + pos) * 128 + hk * 64 + dc * 8);
            *(LAS u32x4*)(Ks + key * 72 + dc * 8) = kv; }
        for (int id = tid; id < 1024; id += NTHR) { const int kp = id >> 3, dc = id & 7; const int pos = n * 128 - 128 + 2 * kp;
            u32x4 v0 = {0u, 0u, 0u, 0u}, v1 = {0u, 0u, 0u, 0u};
            if (pos >= 0) { const size_t o = ((size_t)b * 4096 + pos) * 128 + hk * 64 + dc * 8; v0 = *(const u32x4*)(Vb + o); v1 = *(const u32x4*)(Vb + o + 128); }
            LAS unsigned* vp = (LAS unsigned*)(Vt + (dc * 8) * 280 + 2 * kp);
            vp[0 * 140] = (v0.x & 0xffffu) | (v1.x << 16); vp[1 * 140] = (v0.x >> 16) | (v1.x & 0xffff0000u);
            vp[2 * 140] = (v0.y & 0xffffu) | (v1.y << 16); vp[3 * 140] = (v0.y >> 16) | (v1.y & 0xffff0000u);
            vp[4 * 140] = (v0.z & 0xffffu) | (v1.z << 16); vp[5 * 140] = (v0.z >> 16) | (v1.z & 0xffff0000u);
            vp[6 * 140] = (v0.w & 0xffffu) | (v1.w << 16); vp[7 * 140] = (v0.w >> 16) | (v1.w & 0xffff0000u); }
        for (int id = tid; id < 64 * 8; id += NTHR) *(LAS unsigned*)(Vt + (id >> 3) * 280 + 256 + 2 * (id & 7)) = 0u;
        for (int g = 0; g < 8; ++g) {
            const int hq = hk * 8 + g;
            __syncthreads();
            for (int id = tid; id < 1024; id += NTHR) { const int qi = id >> 3, dc = id & 7;
                *(LAS u32x4*)(Qs + qi * 72 + dc * 8) = *(const u32x4*)(Q + ((size_t)b * 4096 + n * 128 + qi) * 1024 + hq * 64 + dc * 8); }
            __syncthreads();
            const float sink = sinks[hq];
            f32x4 sc[9];
#pragma unroll
            for (int t = 0; t < 9; ++t) { f32x4 a = {0.f, 0.f, 0.f, 0.f};
#pragma unroll
                for (int kc = 0; kc < 2; ++kc) a = mma16(Qs + (16 * w + fr) * 72 + kc * 32 + fq * 8, Ks + (16 * (w + t) + fr) * 72 + kc * 32 + fq * 8, a);
                sc[t] = a; }
            float mx[4] = {-INFINITY, -INFINITY, -INFINITY, -INFINITY};
#pragma unroll
            for (int t = 0; t < 9; ++t)
#pragma unroll
                for (int j = 0; j < 4; ++j) {
                    bool valid = true;
                    if (t == 0) valid = (dq + j) < 0;
                    if (t == 8) valid = (dq + j) >= 0;
                    if (n == 0 && (w + t) < 8) valid = false;
                    const float s = valid ? sc[t][j] * 0.125f : -INFINITY; sc[t][j] = s; mx[j] = fmaxf(mx[j], s); }
            float den[4];
#pragma unroll
            for (int j = 0; j < 4; ++j) { mx[j] = fmaxf(max16(mx[j]), sink); den[j] = 0.f; }
#pragma unroll
            for (int t = 0; t < 9; ++t)
#pragma unroll
                for (int j = 0; j < 4; ++j) { const float pz = __expf(sc[t][j] - mx[j]); sc[t][j] = pz; den[j] += pz; }
#pragma unroll
            for (int j = 0; j < 4; ++j) den[j] = 1.f / (sum16(den[j]) + __expf(sink - mx[j]));
#pragma unroll
            for (int t = 0; t < 9; ++t)
#pragma unroll
                for (int j = 0; j < 4; ++j) Pw[(fq * 4 + j) * 168 + 16 * t + fr] = f2bf(SWT >= 2 ? 0.0078125f + 0.f * den[j] : sc[t][j] * den[j]);
#pragma unroll
            for (int j = 0; j < 4; ++j) Pw[(fq * 4 + j) * 168 + 144 + fr] = 0;
            __syncthreads();
#pragma unroll
            for (int dt = 0; dt < 4; ++dt) { f32x4 a = {0.f, 0.f, 0.f, 0.f};
#pragma unroll
                for (int kc = 0; kc < 5; ++kc) a = mma16(Vt + (dt * 16 + fr) * 280 + 16 * w + kc * 32 + fq * 8, Pw + fr * 168 + kc * 32 + fq * 8, a);
                *(u32x2*)(O + ((size_t)b * 4096 + n * 128 + 16 * w + fr) * 1024 + hq * 64 + dt * 16 + fq * 4) = pk4(a); }
        }
    }
}

__device__ __forceinline__ void phase_sg_stats(const int tid_l, const int bid_l, const float* stp, float* stats) {
    const size_t gt = (size_t)bid_l * NTHR + tid_l, gn = (size_t)gridDim.x * NTHR;
    for (size_t row = gt; row < (size_t)MTOK; row += gn) { const f32x4* p = (const f32x4*)(stp + row * 64); float s1 = 0.f, s2 = 0.f;
#pragma unroll
        for (int q = 0; q < 16; ++q) { const f32x4 t = p[q]; s1 += t[0] + t[2]; s2 += t[1] + t[3]; }
        const float mu = s1 * (1.f / 2048.f), var = s2 * (1.f / 2048.f) - mu * mu;
        *(f32x2*)(stats + row * 2) = (f32x2){mu, rsqrtf(var + EPS)}; }
}
__device__ __forceinline__ void phase_sg_core(const int tid_l, const int bid_l, bf16_t* U, const bf16_t* V, const float* stats, const bf16_t* Wsm, const float* b_s, const float* ln_g, const float* ln_b, LAS unsigned char* lds) {
    LAS bf16_t* Ws = (LAS bf16_t*)lds;
    LAS bf16_t* Vt = (LAS bf16_t*)(lds + 34816);
    const int tid = tid_l, lane = tid & 63, w = tid >> 6, fr = lane & 15, fq = lane >> 4;
    int gprev = -1;
    for (int item = bid_l; item < 4096; item += gridDim.x) {
        const int g = item & 15, n = (item >> 4) & 31, b = item >> 9;
        const size_t t0 = (size_t)b * 4096 + n * 128;
        __syncthreads();
        if (g != gprev) { gprev = g;
            for (int id = tid; id < 2048; id += NTHR) { const int t = id >> 4, sc8 = id & 15;
                *(LAS u32x4*)(Ws + t * 136 + sc8 * 8) = *(const u32x4*)(Wsm + ((size_t)g * 128 + t) * 128 + sc8 * 8); } }
        for (int id = tid; id < 2048; id += NTHR) { const int cc = id >> 7, s = id & 127; const size_t tok = t0 + s;
            const float mu = stats[tok * 2], rstd = stats[tok * 2 + 1];
            const u32x4 raw = *(const u32x4*)(V + tok * 2048 + g * 128 + cc * 8);
            const float* lg = ln_g + g * 128 + cc * 8; const float* lb = ln_b + g * 128 + cc * 8;
            const unsigned rw[4] = {raw.x, raw.y, raw.z, raw.w};
#pragma unroll
            for (int q = 0; q < 4; ++q) { const float v0 = (bflo(rw[q]) - mu) * rstd * lg[2 * q] + lb[2 * q], v1 = (bfhi(rw[q]) - mu) * rstd * lg[2 * q + 1] + lb[2 * q + 1];
                Vt[(cc * 8 + 2 * q) * 136 + s] = f2bf(v0); Vt[(cc * 8 + 2 * q + 1) * 136 + s] = f2bf(v1); } }
        __syncthreads();
        const int kmax = (16 * w + 15) >> 5;
        const int trow = 16 * w + fr; const float bs = b_s[g * 128 + trow];
#pragma unroll
        for (int ct = 0; ct < 8; ++ct) { f32x4 a = {0.f, 0.f, 0.f, 0.f};
            for (int kc = 0; kc <= kmax; ++kc) a = mma16(Vt + (ct * 16 + fr) * 136 + kc * 32 + fq * 8, Ws + (16 * w + fr) * 136 + kc * 32 + fq * 8, a);
            bf16_t* up = U + (t0 + trow) * 2048 + g * 128 + ct * 16 + fq * 4;
            *(u32x2*)up = pk4(unpk4(*(const u32x2*)up) * (a + bs)); }
    }
}

constexpr int GLD = 3328;
constexpr int BCS = 129;
__device__ __forceinline__ void gla_bcum(const int tid_l, const bf16_t* proj, size_t t0, int h, const float* w_a2, const float* b_a, LAS float* bc, LAS float* al, LAS float* gtot) {
    const int tid = tid_l, k = tid & 127, ig = tid >> 7;
    for (int id = tid; id < 1024; id += NTHR) al[id] = bf2f(proj[(t0 + (id >> 4)) * GLD + 3072 + (id & 15)]);
    float wj[16];
#pragma unroll
    for (int j = 0; j < 16; ++j) wj[j] = w_a2[(size_t)j * 512 + h * 128 + k];
    const float ba = b_a[h * 128 + k];
    __syncthreads();
    float run = 0.f;
#pragma unroll 4
    for (int ii = 0; ii < 16; ++ii) { const int i = ig * 16 + ii; const LAS f32x4* ap = (const LAS f32x4*)(al + i * 16); const f32x4 a0 = ap[0], a1 = ap[1], a2 = ap[2], a3 = ap[3];
        float z = ba;
        z += a0[0] * wj[0] + a0[1] * wj[1] + a0[2] * wj[2] + a0[3] * wj[3]; z += a1[0] * wj[4] + a1[1] * wj[5] + a1[2] * wj[6] + a1[3] * wj[7];
        z += a2[0] * wj[8] + a2[1] * wj[9] + a2[2] * wj[10] + a2[3] * wj[11]; z += a3[0] * wj[12] + a3[1] * wj[13] + a3[2] * wj[14] + a3[3] * wj[15];
        run += -softplusf_(-z) * (1.f / 16.f); bc[i * BCS + k] = run; }
    gtot[ig * 128 + k] = run;
    __syncthreads();
    float off = 0.f;
    for (int g = 0; g < ig; ++g) off += gtot[g * 128 + k];
    if (ig > 0) {
#pragma unroll 4
        for (int ii = 0; ii < 16; ++ii) bc[(ig * 16 + ii) * BCS + k] += off; }
    __syncthreads();
}
__device__ __forceinline__ void phase_gla1(const int tid_l, const int bid_l, const bf16_t* proj, const float* w_a2, const float* b_a, bf16_t* dS, float* gdc, LAS unsigned char* lds) {
    LAS float* bc = (LAS float*)lds;
    LAS float* al = (LAS float*)(lds + 33280);
    LAS float* wa2 = (LAS float*)(lds + 37376);
    LAS bf16_t* KsT = (LAS bf16_t*)(lds + 45056);
    LAS bf16_t* Vt = (LAS bf16_t*)(lds + 45056 + 18432);
    const int tid = tid_l, lane = tid & 63, w = tid >> 6, fr = lane & 15, fq = lane >> 4;
    for (int item = bid_l; item < 2048; item += gridDim.x) {
        const int h = item & 3, bn = item >> 2; const size_t t0 = (size_t)bn * 64;
        __syncthreads();
        gla_bcum(tid_l, proj, t0, h, w_a2, b_a, bc, al, wa2);
        for (int id = tid; id < 1024; id += NTHR) { const int kc8 = id >> 6, j = id & 63; const u32x4 raw = *(const u32x4*)(proj + (t0 + j) * GLD + 512 + h * 128 + kc8 * 8); const unsigned rw[4] = {raw.x, raw.y, raw.z, raw.w};
#pragma unroll
            for (int q = 0; q < 4; ++q) { const int k0 = kc8 * 8 + 2 * q;
                KsT[k0 * 72 + j] = f2bf(bflo(rw[q]) * __expf(bc[63 * BCS + k0] - bc[j * BCS + k0]));
                KsT[(k0 + 1) * 72 + j] = f2bf(bfhi(rw[q]) * __expf(bc[63 * BCS + k0 + 1] - bc[j * BCS + k0 + 1])); } }
        for (int id = tid; id < 2048; id += NTHR) { const int vc8 = id >> 6, j = id & 63; const u32x4 raw = *(const u32x4*)(proj + (t0 + j) * GLD + 1024 + h * 256 + vc8 * 8); const unsigned rw[4] = {raw.x, raw.y, raw.z, raw.w};
#pragma unroll
            for (int q = 0; q < 4; ++q) { Vt[(vc8 * 8 + 2 * q) * 72 + j] = (bf16_t)(rw[q] & 0xffff); Vt[(vc8 * 8 + 2 * q + 1) * 72 + j] = (bf16_t)(rw[q] >> 16); } }
        if (tid < 128) gdc[(size_t)item * 128 + tid] = __expf(bc[63 * BCS + tid]);
        __syncthreads();
#pragma unroll
        for (int vi = 0; vi < 2; ++vi) { const int vt = 2 * w + vi;
#pragma unroll
            for (int kt = 0; kt < 8; ++kt) { f32x4 a = {0.f, 0.f, 0.f, 0.f};
#pragma unroll
                for (int kc = 0; kc < 2; ++kc) a = mma16(KsT + (kt * 16 + fr) * 72 + kc * 32 + fq * 8, Vt + (vt * 16 + fr) * 72 + kc * 32 + fq * 8, a);
                *(u32x2*)(dS + (size_t)item * 32768 + (size_t)(vt * 16 + fr) * 128 + kt * 16 + fq * 4) = pk4(a); } }
    }
}
__device__ __forceinline__ void phase_gla2(const int tid_l, const int bid_l, bf16_t* dS, const float* gdc) {
    const size_t gt = (size_t)bid_l * NTHR + tid_l, gn = (size_t)gridDim.x * NTHR;
    for (size_t i = gt; i < (size_t)32 * 4096; i += gn) {
        const int bh = (int)(i >> 12), e0 = (int)(i & 4095) * 8, b = bh >> 2, h = bh & 3, k0 = e0 & 127;
        float s[8];
#pragma unroll
        for (int q = 0; q < 8; ++q) s[q] = 0.f;
#pragma unroll 8
        for (int n = 0; n < 64; ++n) { const size_t item = ((size_t)b * 64 + n) * 4 + h; bf16_t* ptr = dS + item * 32768 + e0;
            const u32x4 raw = *(const u32x4*)ptr; const f32x4 d0 = *(const f32x4*)(gdc + item * 128 + k0), d1 = *(const f32x4*)(gdc + item * 128 + k0 + 4);
            u32x4 o; o.x = pk2(s[0], s[1]); o.y = pk2(s[2], s[3]); o.z = pk2(s[4], s[5]); o.w = pk2(s[6], s[7]); *(u32x4*)ptr = o;
            s[0] = s[0] * d0[0] + bflo(raw.x); s[1] = s[1] * d0[1] + bfhi(raw.x); s[2] = s[2] * d0[2] + bflo(raw.y); s[3] = s[3] * d0[3] + bfhi(raw.y);
            s[4] = s[4] * d1[0] + bflo(raw.z); s[5] = s[5] * d1[1] + bfhi(raw.z); s[6] = s[6] * d1[2] + bflo(raw.w); s[7] = s[7] * d1[3] + bfhi(raw.w); }
    }
}
__device__ __forceinline__ void phase_gla3(const int tid_l, const int bid_l, bf16_t* proj, const float* w_a2, const float* b_a, const bf16_t* dS, const float* gn_g, LAS unsigned char* lds) {
    LAS float* bc = (LAS float*)lds;
    LAS float* al = (LAS float*)(lds + 33280);
    LAS float* wa2 = (LAS float*)(lds + 37376);
    LAS bf16_t* Qg = (LAS bf16_t*)(lds + 45056);
    LAS bf16_t* Kg = (LAS bf16_t*)(lds + 62464);
    LAS bf16_t* At = (LAS bf16_t*)(lds + 79872);
    LAS bf16_t* Vt = (LAS bf16_t*)(lds + 89088);
    LAS bf16_t* St = (LAS bf16_t*)(lds + 107520);
    LAS float* ssq = (LAS float*)(lds + 142336);
    const int tid = tid_l, lane = tid & 63, w = tid >> 6, fr = lane & 15, fq = lane >> 4;
    for (int item = bid_l; item < 2048; item += gridDim.x) {
        const int h = item & 3, bn = item >> 2; const size_t t0 = (size_t)bn * 64;
        __syncthreads();
        gla_bcum(tid_l, proj, t0, h, w_a2, b_a, bc, al, wa2);
        for (int id = tid; id < 1024; id += NTHR) { const int i = id >> 4, kc8 = id & 15;
            const u32x4 rq = *(const u32x4*)(proj + (t0 + i) * GLD + h * 128 + kc8 * 8), rk = *(const u32x4*)(proj + (t0 + i) * GLD + 512 + h * 128 + kc8 * 8);
            const unsigned q4[4] = {rq.x, rq.y, rq.z, rq.w}, k4[4] = {rk.x, rk.y, rk.z, rk.w}; unsigned oq[4], ok[4];
#pragma unroll
            for (int q = 0; q < 4; ++q) { const float b0 = bc[i * BCS + kc8 * 8 + 2 * q], b1 = bc[i * BCS + kc8 * 8 + 2 * q + 1]; const float e0 = __expf(b0), e1 = __expf(b1);
                oq[q] = pk2(bflo(q4[q]) * 0.08838834764831845f * e0, bfhi(q4[q]) * 0.08838834764831845f * e1);
                ok[q] = pk2(bflo(k4[q]) / e0, bfhi(k4[q]) / e1); }
            *(LAS u32x4*)(Qg + i * 136 + kc8 * 8) = (u32x4){oq[0], oq[1], oq[2], oq[3]}; *(LAS u32x4*)(Kg + i * 136 + kc8 * 8) = (u32x4){ok[0], ok[1], ok[2], ok[3]}; }
        __syncthreads();
        { const int it = w >> 1;
#pragma unroll
          for (int x = 0; x < 2; ++x) { const int jt = (w & 1) * 2 + x; f32x4 a = {0.f, 0.f, 0.f, 0.f};
#pragma unroll
              for (int kc = 0; kc < 4; ++kc) a = mma16(Qg + (it * 16 + fr) * 136 + kc * 32 + fq * 8, Kg + (jt * 16 + fr) * 136 + kc * 32 + fq * 8, a);
#pragma unroll
              for (int j = 0; j < 4; ++j) { const int i = it * 16 + fq * 4 + j, jj = jt * 16 + fr; At[i * 72 + jj] = f2bf(jj <= i ? a[j] : 0.f); } } }
        const int rb = w & 3, cq = w >> 2;
        f32x4 oacc[8];
#pragma unroll
        for (int x = 0; x < 8; ++x) oacc[x] = (f32x4){0.f, 0.f, 0.f, 0.f};
#pragma unroll
        for (int half = 0; half < 2; ++half) {
            __syncthreads();
            for (int id = tid; id < 1024; id += NTHR) { const int vc8 = id >> 6, j = id & 63; const u32x4 raw = *(const u32x4*)(proj + (t0 + j) * GLD + 1024 + h * 256 + half * 128 + vc8 * 8); const unsigned rw[4] = {raw.x, raw.y, raw.z, raw.w};
#pragma unroll
                for (int q = 0; q < 4; ++q) { Vt[(vc8 * 8 + 2 * q) * 72 + j] = (bf16_t)(rw[q] & 0xffff); Vt[(vc8 * 8 + 2 * q + 1) * 72 + j] = (bf16_t)(rw[q] >> 16); } }
            for (int id = tid; id < 2048; id += NTHR) { const int v = id >> 4, kc8 = id & 15;
                *(LAS u32x4*)(St + v * 136 + kc8 * 8) = *(const u32x4*)(dS + (size_t)item * 32768 + (size_t)(half * 128 + v) * 128 + kc8 * 8); }
            __syncthreads();
#pragma unroll
            for (int x = 0; x < 4; ++x) { const int vt = cq * 4 + x; f32x4 a = oacc[half * 4 + x];
#pragma unroll
                for (int kc = 0; kc < 2; ++kc) a = mma16(Vt + (vt * 16 + fr) * 72 + kc * 32 + fq * 8, At + (rb * 16 + fr) * 72 + kc * 32 + fq * 8, a);
#pragma unroll
                for (int kc = 0; kc < 4; ++kc) a = mma16(St + (vt * 16 + fr) * 136 + kc * 32 + fq * 8, Qg + (rb * 16 + fr) * 136 + kc * 32 + fq * 8, a);
                oacc[half * 4 + x] = a; }
        }
        { float sacc = 0.f;
#pragma unroll
          for (int x = 0; x < 8; ++x) sacc += (oacc[x][0] * oacc[x][0] + oacc[x][1] * oacc[x][1]) + (oacc[x][2] * oacc[x][2] + oacc[x][3] * oacc[x][3]);
          sacc = xrow_sum(sacc);
          if (fq == 0) ssq[(rb * 16 + fr) * 2 + cq] = sacc; }
        __syncthreads();
        { const int i = rb * 16 + fr; const float rstd = rsqrtf((ssq[i * 2] + ssq[i * 2 + 1]) * (1.f / 256.f) + EPS);
#pragma unroll
          for (int x = 0; x < 8; ++x) { const int v0 = (x >> 2) * 128 + (cq * 4 + (x & 3)) * 16 + fq * 4; bf16_t* gp = proj + (t0 + i) * GLD + 2048 + h * 256 + v0;
              const f32x4 gate = unpk4(*(const u32x2*)gp), gg = *(const f32x4*)(gn_g + h * 256 + v0); f32x4 z;
#pragma unroll
              for (int j = 0; j < 4; ++j) z[j] = oacc[x][j] * rstd * gg[j] * (gate[j] * __builtin_amdgcn_rcpf(1.f + __expf(-gate[j])));
              *(u32x2*)gp = pk4(z); } }
    }
}


#define XB_TMO      128
#define XB_XCNT(j)  (256  + 64 * (j))
#define XB_XSUB(j)  (1280 + 64 * (j))
#define XB_XGEN(j)  (2304 + 64 * (j))
#define XB_TOP      3328
#define XB_TOPGEN   3392
#define XCD_BAR_WORDS 3456
#define XB_SPIN_CAP (1u << 18)
__device__ __forceinline__ unsigned xb_ld(unsigned* p)              { return __hip_atomic_load(p, __ATOMIC_RELAXED, __HIP_MEMORY_SCOPE_AGENT); }
__device__ __forceinline__ unsigned xb_add(unsigned* p, unsigned v) { return __hip_atomic_fetch_add(p, v, __ATOMIC_RELAXED, __HIP_MEMORY_SCOPE_AGENT); }
__device__ __forceinline__ unsigned xb_xcc_id() { return (unsigned)__builtin_amdgcn_s_getreg((3 << 11) | 20) & 0xFu; }
#define XB_SPIN(cond, bar) do { unsigned _sp = 0; while (cond) { __builtin_amdgcn_s_sleep(1); \
    if ((++_sp & 255u) == 0u) { if (xb_ld(&(bar)[XB_TMO])) break; if (_sp > XB_SPIN_CAP) { atomicAdd(&(bar)[XB_TMO], 1u); break; } } } } while (0)
struct XcdBarrier { unsigned* bar; unsigned x; volatile LAS unsigned* st; };
__device__ __forceinline__ void xcd_barrier_complete(unsigned* bar, unsigned x, unsigned& nloc, unsigned& nx) {
    const unsigned G = gridDim.x * gridDim.y * gridDim.z;
    unsigned sum, cnt, mine, sp = 0u;
    for (;;) {
        sum = 0u; cnt = 0u; mine = 0u;
#pragma unroll
        for (unsigned j = 0; j < 16; ++j) { const unsigned c = xb_ld(&bar[XB_XCNT(j)]); sum += c; cnt += (c > 0u) ? 1u : 0u; mine = (j == x) ? c : mine; }
        if (sum == G) break;
        __builtin_amdgcn_s_sleep(1);
        if ((++sp & 255u) == 0u) { if (xb_ld(&bar[XB_TMO])) break; if (sp > XB_SPIN_CAP) { atomicAdd(&bar[XB_TMO], 1u); break; } }
    }
    nloc = mine > 0u ? mine : 1u; nx = cnt > 0u ? cnt : 1u;
}
__device__ __forceinline__ void xcd_barrier(const XcdBarrier& b) {
    asm volatile("s_waitcnt vmcnt(0)" ::: "memory");
    __syncthreads();
    if (threadIdx.x == 0) {
        unsigned* bar = b.bar;
        __builtin_amdgcn_s_waitcnt(0);
        unsigned nloc = b.st[0], nx = b.st[1];
        if (nloc == 0u) { xcd_barrier_complete(bar, b.x, nloc, nx); b.st[0] = nloc; b.st[1] = nx; }
        const unsigned old = xb_add(&bar[XB_XSUB(b.x)], 1u);
        const unsigned gen = old / nloc;
        if (old + 1u == (gen + 1u) * nloc) {
            __builtin_amdgcn_fence(__ATOMIC_RELEASE, "agent");
            asm volatile("s_waitcnt vmcnt(0)" ::: "memory");
            const unsigned og = xb_add(&bar[XB_TOP], 1u);
            const unsigned tg = og / nx;
            if (og + 1u == (tg + 1u) * nx) xb_add(&bar[XB_TOPGEN], 1u);
            else XB_SPIN(xb_ld(&bar[XB_TOPGEN]) == tg, bar);
            __builtin_amdgcn_fence(__ATOMIC_ACQUIRE, "agent");
            xb_add(&bar[XB_XGEN(b.x)], 1u);
            asm volatile("s_waitcnt vmcnt(0)" ::: "memory");
        } else {
            XB_SPIN(xb_ld(&bar[XB_XGEN(b.x)]) == gen, bar);
            __builtin_amdgcn_fence(__ATOMIC_ACQUIRE, "agent");
            asm volatile("s_waitcnt vmcnt(0)" ::: "memory");
        }
    }
    __syncthreads();
}
constexpr int XBST_OFF = 147296;

#define LAUNDER() asm volatile("" : "+v"(tid_l), "+s"(bid_l) :: "memory")
constexpr int NPHASE = 34;
#ifndef PHMASK
#define PHMASK 0xFFFFFFFFFFFFFFFFull
#endif
#define ON(n) ((((unsigned long long)(PHMASK)) >> (n)) & 1ull)
template <int PH> __device__ __forceinline__ void do_phase(const LAS unsigned long long* ptab, LAS unsigned char* lds) {
    constexpr int ph = PH;

        int tid_l = threadIdx.x, bid_l = blockIdx.x; LAUNDER();
        float* const H = (float*)inp(ptab, 41);
        unsigned char* const ws = (unsigned char*)inp(ptab, 42);
        bf16_t* const A0 = (bf16_t*)SLOTP(0); bf16_t* const A1 = (bf16_t*)SLOTP(1); bf16_t* const A2 = (bf16_t*)SLOTP(2); bf16_t* const A3 = (bf16_t*)SLOTP(3); bf16_t* const A4 = (bf16_t*)SLOTP(4); bf16_t* const A5 = (bf16_t*)SLOTP(5);
        int fl = -1, fp = 0;
        if (ph >= 7 && ph <= 9) { fl = 0; fp = ph - 7; } else if (ph >= 14 && ph <= 16) { fl = 1; fp = ph - 14; } else if (ph >= 21 && ph <= 23) { fl = 2; fp = ph - 21; } else if (ph >= 30 && ph <= 32) { fl = 3; fp = ph - 30; }
        if (fl >= 0) {
            if (fp == 0) { if (ON(7)) phase_norm(tid_l, bid_l, H, inp(ptab, 3) + fl * 1024, A0); }
            else if (fp == 1) { if (ON(8)) pg8::gemm_phase(tid_l, bid_l, lds, Gemm{A0, (const bf16_t*)(ws + W_FFN_IN) + (size_t)fl * 5632 * 1024, MTOK, 5632, 1024, 1024, 0, 0}, EpiSwiglu{A1}); }
            else { if (ON(9)) pg8::gemm_phase(tid_l, bid_l, lds, Gemm{A1, (const bf16_t*)(ws + W_FFN_OUT) + (size_t)fl * 1024 * 2816, MTOK, 1024, 2816, 2816, 0, 0}, EpiResid{H, H, nullptr}); }
            return;
        }
        switch (ph) {
        case 0: if (ON(0)) { phase_prep(tid_l, bid_l, ptab, ws, lds); } break;
        case 1: if (ON(1)) { phase_rw_norm(tid_l, bid_l, inp(ptab, 0), inp(ptab, 2), inp(ptab, 7), A0, (bf16_t*)H, (bf16_t*)H + (size_t)MTOK * 1024, A1); } break;
        case 2: if (ON(2)) {
            const bf16_t* wr = (const bf16_t*)(ws + W_RKV);
            pg8::gemm_phase(tid_l, bid_l, lds, Gemm{(const bf16_t*)H, wr, MTOK, 1024, 1024, 1024, 0, 0}, EpiBf16{A2, 1024}); LAUNDER();
            pg8::gemm_phase(tid_l, bid_l, lds, Gemm{(const bf16_t*)H + (size_t)MTOK * 1024, wr + (size_t)1024 * 1024, MTOK, 1024, 1024, 1024, 0, 0}, EpiBf16{A3, 1024}); LAUNDER();
            pg8::gemm_phase(tid_l, bid_l, lds, Gemm{A1, wr + (size_t)2 * 1024 * 1024, MTOK, 1024, 1024, 1024, 0, 1}, EpiBf16{A4, 1024}); LAUNDER();
            pg8::gemm_phase(tid_l, bid_l, lds, Gemm{A0, (const bf16_t*)(ws + W_L1), MTOK, 256, 2048, 1024, 1, 0}, EpiLora1{A5});
        } break;
        case 3: if (ON(3)) { pg8::gemm_phase(tid_l, bid_l, lds, Gemm{A5, (const bf16_t*)(ws + W_L2), MTOK, 3072, 256, 256, 0, 0}, EpiLora2{H, A0, A1, inp(ptab, 9), inp(ptab, 12)}); } break;
        case 4: if (ON(4)) { phase_rw_scan(tid_l, bid_l, A2, A3, A4, A0, H, inp(ptab, 17), inp(ptab, 18), A5, lds, ptab, ws); } break;
        case 5: if (ON(5)) { phase_rw_post(tid_l, bid_l, A5, A2, A3, A4, A0, A1, inp(ptab, 18), inp(ptab, 19), inp(ptab, 20), inp(ptab, 21), A5); } break;
        case 6: if (ON(6)) { pg8::gemm_phase(tid_l, bid_l, lds, Gemm{A5, (const bf16_t*)(ws + W_RWO), MTOK, 1024, 1024, 1024, 0, 0}, EpiResid{inp(ptab, 0), H, nullptr}); } break;
        case 10: if (ON(10)) { phase_norm(tid_l, bid_l, H, inp(ptab, 2) + 1024, A0); } break;
        case 11: if (ON(11)) { pg8::gemm_phase(tid_l, bid_l, lds, Gemm{A0, (const bf16_t*)(ws + W_QKV), MTOK, 1280, 1024, 1024, 0},
                                 EpiQKV{A1, A2, A2 + (size_t)16 * 1024 * 1024, inp(ptab, 24), (const float*)(ws + T_COS), (const float*)(ws + T_SIN)}); } break;
        case 12: if (ON(12)) {
#ifdef SW_COPY
            { const size_t gt = (size_t)bid_l * NTHR + tid_l, gn = (size_t)gridDim.x * NTHR; const u32x4* src = (const u32x4*)A1; u32x4* dst = (u32x4*)A3; for (size_t i = gt; i < (size_t)MTOK * 1024 / 8; i += gn) { const size_t row = i >> 7; const int c8 = (int)(i & 127); const u32x4 kq = *(const u32x4*)(A2 + row * 128 + (c8 & 15) * 8), vq = *(const u32x4*)(A2 + (size_t)16 * 1024 * 1024 + row * 128 + (c8 & 15) * 8); u32x4 o = src[i]; o.x ^= kq.x + vq.y; o.y = kq.y; o.z = vq.z; o.w ^= kq.w ^ vq.x; dst[i] = o; } }
#else
            phase_sw_att(tid_l, bid_l, A1, A2, A2 + (size_t)16 * 1024 * 1024, inp(ptab, 25), A3, lds);
#endif
            } break;
        case 13: if (ON(13)) { pg8::gemm_phase(tid_l, bid_l, lds, Gemm{A3, (const bf16_t*)(ws + W_SWO), MTOK, 1024, 1024, 1024, 0, 0}, EpiResid{H, H, inp(ptab, 27)}); } break;
        case 17: if (ON(17)) { phase_norm(tid_l, bid_l, H, inp(ptab, 2) + 2048, A0); } break;
        case 18: if (ON(18)) { pg8::gemm_phase(tid_l, bid_l, lds, Gemm{A0, (const bf16_t*)(ws + W_SGIN), MTOK, 4096, 1024, 1024, 0, 0}, EpiSGUin{A1, A3, inp(ptab, 29), (float*)(ws + T_STP)}); } break;
        case 19: if (ON(19)) {
            phase_sg_stats(tid_l, bid_l, (const float*)(ws + T_STP), (float*)(ws + T_STATS));
            { XcdBarrier xb; xb.bar = (unsigned*)(ws + T_BAR); xb.x = xb_xcc_id(); xb.st = (volatile LAS unsigned*)(lds + XBST_OFF); xcd_barrier(xb); }
            phase_sg_core(tid_l, bid_l, A1, A3, (const float*)(ws + T_STATS), (const bf16_t*)(ws + W_SGS), inp(ptab, 33), inp(ptab, 30), inp(ptab, 31), lds); } break;
        case 20: if (ON(20)) { pg8::gemm_phase(tid_l, bid_l, lds, Gemm{A1, (const bf16_t*)(ws + W_SGO), MTOK, 1024, 2048, 2048, 0, 0}, EpiResid{H, H, inp(ptab, 35)}); } break;
        case 24: if (ON(24)) { phase_norm(tid_l, bid_l, H, inp(ptab, 2) + 3072, A5); } break;
        case 25: if (ON(25)) { pg8::gemm_phase(tid_l, bid_l, lds, Gemm{A5, (const bf16_t*)(ws + W_GLIN), MTOK, 3328, 1024, 1024, 0, 0}, EpiBf16{A0, GLD}); } break;
        case 26: if (ON(26)) { phase_gla1(tid_l, bid_l, A0, inp(ptab, 37), inp(ptab, 38), A4, (float*)(ws + T_GDC), lds); } break;
        case 27: if (ON(27) && GT != 3) { phase_gla2(tid_l, bid_l, A4, (const float*)(ws + T_GDC)); } break;
        case 28: if (ON(28) && GT != 1) { phase_gla3(tid_l, bid_l, A0, inp(ptab, 37), inp(ptab, 38), A4, inp(ptab, 39), lds); } break;
        case 29: if (ON(29)) { pg8::gemm_phase(tid_l, bid_l, lds, Gemm{A0 + 2048, (const bf16_t*)(ws + W_GLO), MTOK, 1024, 1024, GLD, 0, 0}, EpiResid{H, H, nullptr}); } break;
        case 33: if (ON(33)) { phase_final(tid_l, bid_l, H, inp(ptab, 6)); } break;
        default: break;
        }
}
template <int PH, int HI> __device__ __forceinline__ void run_phases(cg::grid_group& grid, const LAS unsigned long long* ptab, LAS unsigned char* lds, bool first, unsigned nbar = 0) {
    if constexpr (PH < HI) {
        if (!first && PH != 1) {
            XcdBarrier xb; xb.bar = (unsigned*)((unsigned char*)inp(ptab, 42) + T_BAR); xb.x = xb_xcc_id(); xb.st = (volatile LAS unsigned*)(lds + XBST_OFF);
            xcd_barrier(xb);
        }
        do_phase<PH>(ptab, lds);
#ifdef REP_PH
        if (((REP_PH) >> PH) & 1ull) { __syncthreads(); do_phase<PH>(ptab, lds); }
#endif
        run_phases<PH + 1, HI>(grid, ptab, lds, false, nbar + 1);
    }
}
template <int LO, int HI> __global__ void __launch_bounds__(512, 2) mega(Params p) {
    extern __shared__ __attribute__((aligned(16))) unsigned char smem[];
    LAS unsigned char* lds = (LAS unsigned char*)smem;
    cg::grid_group grid = cg::this_grid();
    LAS unsigned long long* ptab = (LAS unsigned long long*)(lds + PTAB_OFF);
    { const int t = threadIdx.x;
#pragma unroll
      for (int i = 0; i < 41; ++i) { if (t == i) ptab[i] = (unsigned long long)p.in[i]; if ((i & 3) == 3) asm volatile("" ::: "memory"); }
      if (t == 41) ptab[41] = (unsigned long long)p.out;
      if (t == 42) ptab[42] = (unsigned long long)p.ws; }
    if (threadIdx.x == 0) { *(LAS unsigned*)(lds + XBST_OFF) = 0u; *(LAS unsigned*)(lds + XBST_OFF + 4) = 0u; }
    __syncthreads();
    if (threadIdx.x == 0) (void)xb_add(&((unsigned*)(p.ws + T_BAR))[XB_XCNT(xb_xcc_id())], 1u);
    grid.sync();
#ifdef TRUNC_AT
    run_phases<LO, TRUNC_AT>(grid, ptab, lds, true);
    run_phases<33, 34>(grid, ptab, lds, false, TRUNC_AT);
#else
    run_phases<LO, HI>(grid, ptab, lds, true);
#endif
}

extern "C" void kernel_launch(void* const* d_in, const int* in_sizes, int n_in, void* d_out, int out_size, void* d_ws, size_t ws_size, hipStream_t stream) {
    static int grid = 0;
    if (grid == 0) {
        if (n_in != 41 || ws_size < WS_END) { fprintf(stderr, "kernel_launch: unexpected inputs (n_in %d, ws %zu, need %zu)\n", n_in, ws_size, (size_t)WS_END); grid = -1; return; }
        int dev = 0, cus = 0, per_cu = 0;
        hipGetDevice(&dev); hipDeviceGetAttribute(&cus, hipDeviceAttributeMultiprocessorCount, dev);
        if (hipFuncSetAttribute((const void*)mega<0, NPHASE>, hipFuncAttributeMaxDynamicSharedMemorySize, LDS_BYTES) != hipSuccess) { fprintf(stderr, "kernel_launch: hipFuncSetAttribute failed\n"); grid = -1; return; }
        if (hipOccupancyMaxActiveBlocksPerMultiprocessor(&per_cu, (const void*)mega<0, NPHASE>, NTHR, LDS_BYTES) != hipSuccess || per_cu < 1) { fprintf(stderr, "kernel_launch: occupancy query says %d\n", per_cu); per_cu = 1; }
        (void)hipGetLastError();
        grid = cus;
    }
    if (grid < 0) return;
    (void)hipMemsetAsync((unsigned char*)d_ws + T_BAR, 0, XCD_BAR_WORDS * 4, stream);
    Params p{};
    for (int i = 0; i < 41; ++i) p.in[i] = (const float*)d_in[i];
    p.out = (float*)d_out; p.ws = (unsigned char*)d_ws; p.ph_lo = 0; p.ph_hi = NPHASE;
    void* args[] = {&p};
    hipError_t e = hipLaunchCooperativeKernel((const void*)mega<0, NPHASE>, dim3(grid), dim3(NTHR), args, LDS_BYTES, stream);
    if (e != hipSuccess) fprintf(stderr, "cooperative launch failed: %s (grid %d)\n", hipGetErrorString(e), grid);
}
```
